# Optimizing an MI355X kernel written in HIP

```python
import jax, jax.numpy as jnp
from jax import lax
import numpy as np

D_MODEL = 1024
BATCH = 2
SEQ = 8192
DEPTH = 1

HEAD_DIM = 64
SWA_Q_HEADS = 8
SWA_KV_HEADS = 2
SWA_GROUP = SWA_Q_HEADS // SWA_KV_HEADS
WINDOW = 128
BLOCK = 128
FOX_HEADS = 8
ROPE_THETA = 10000.0
SWA_Q_W = SWA_Q_HEADS * HEAD_DIM
SWA_KV_W = SWA_KV_HEADS * HEAD_DIM
FOX_W = FOX_HEADS * HEAD_DIM
MIX_WIDTH = SWA_Q_W + FOX_W
IN_PROJ_W = SWA_Q_W + 2 * SWA_KV_W + 3 * FOX_W + FOX_HEADS

PEER_HEADS = 8
PEER_N_KEYS = 128
PEER_N_EXPERTS = PEER_N_KEYS ** 2
PEER_QUERY_DIM = 256
PEER_HALF = PEER_QUERY_DIM // 2
PEER_TOPK = 16
PEER_CHUNK = 128

PLE_DIM = 256

RMS_EPS = 1e-6

kernel_name = "hymba_swa_fox_peer_layer"


def rmsnorm(x, g):
    xf = x.astype(jnp.float32)
    r = xf * lax.rsqrt(jnp.mean(xf * xf, axis=-1, keepdims=True) + RMS_EPS)
    return (r * g.astype(jnp.float32)).astype(x.dtype)


def rope_tables(seq):
    pos = jnp.arange(seq, dtype=jnp.float32)
    inv_freq = ROPE_THETA ** (-jnp.arange(0, HEAD_DIM, 2, dtype=jnp.float32) / HEAD_DIM)
    ang = pos[:, None] * inv_freq[None, :]
    ang = jnp.concatenate([ang, ang], axis=-1)
    return jnp.cos(ang), jnp.sin(ang)


def apply_rope(t, cos, sin):
    tf = t.astype(jnp.float32)
    t1, t2 = jnp.split(tf, 2, axis=-1)
    rot = jnp.concatenate([-t2, t1], axis=-1)
    out = tf * cos[None, :, None, :] + rot * sin[None, :, None, :]
    return out.astype(t.dtype)


def swa_sink_attention(q, k, v, sinks):
    B, S = q.shape[0], q.shape[1]
    nb = S // BLOCK
    qb = q.reshape(B, nb, BLOCK, SWA_KV_HEADS, SWA_GROUP, HEAD_DIM)

    def band(t):
        tb = t.reshape(B, nb, BLOCK, SWA_KV_HEADS, HEAD_DIM)
        prev = jnp.pad(tb[:, :-1], ((0, 0), (1, 0), (0, 0), (0, 0), (0, 0)))
        return jnp.concatenate([prev, tb], axis=2)

    kb, vb = band(k), band(v)
    s = jnp.einsum('bnqhgd,bnkhd->bnhgqk', qb, kb,
                   preferred_element_type=jnp.float32) * (HEAD_DIM ** -0.5)
    qi = jnp.arange(BLOCK)[:, None] + BLOCK
    ki = jnp.arange(2 * BLOCK)[None, :]
    rel = qi - ki
    in_window = (rel >= 0) & (rel < WINDOW)
    blk = jnp.arange(nb)
    real_key = (blk[:, None] > 0) | (ki >= BLOCK)
    mask = in_window[None] & real_key[:, None, :]
    s = jnp.where(mask[None, :, None, None], s, -jnp.inf)
    sk = sinks.astype(jnp.float32).reshape(1, 1, SWA_KV_HEADS, SWA_GROUP, 1, 1)
    m = jnp.maximum(jnp.max(s, axis=-1, keepdims=True), sk)
    e = jnp.exp(s - m)
    w = e / (jnp.sum(e, axis=-1, keepdims=True) + jnp.exp(sk - m))
    o = jnp.einsum('bnhgqk,bnkhd->bnqhgd', w.astype(v.dtype), vb)
    return o.reshape(B, S, SWA_Q_HEADS, HEAD_DIM)


def forgetting_attention(q, k, v, log_f):
    B, S, H, dh = q.shape
    nb = S // BLOCK
    c = jnp.cumsum(log_f, axis=1)
    c_keys = jnp.transpose(c, (0, 2, 1))
    qb = jnp.transpose(q.reshape(B, nb, BLOCK, H, dh), (1, 0, 2, 3, 4))
    cb = jnp.transpose(c.reshape(B, nb, BLOCK, H), (1, 0, 3, 2))
    kpos = jnp.arange(S)
    scale = dh ** -0.5

    def one_block(args):
        qi, ci, start = args
        s = jnp.einsum('bqhd,bkhd->bhqk', qi, k, preferred_element_type=jnp.float32) * scale
        s = s + ci[..., None] - c_keys[:, :, None, :]
        qpos = start + jnp.arange(BLOCK)
        s = jnp.where(qpos[:, None] >= kpos[None, :], s, -jnp.inf)
        w = jax.nn.softmax(s, axis=-1).astype(v.dtype)
        return jnp.einsum('bhqk,bkhd->bqhd', w, v)

    out = lax.map(one_block, (qb, cb, jnp.arange(nb) * BLOCK))
    return jnp.transpose(out, (1, 0, 2, 3, 4)).reshape(B, S, H, dh)


def peer(xn, w_query, sub_keys, expert_u, expert_v):
    B, S, D = xn.shape
    T = B * S
    K = PEER_TOPK
    xt = xn.reshape(T, D)
    q = (xt @ w_query).reshape(T, PEER_HEADS, 2, PEER_HALF)
    scores = jnp.einsum('thcd,ckd->thck', q, sub_keys,
                        preferred_element_type=jnp.float32)
    top_s, top_i = lax.top_k(scores, K)
    cand_s = (top_s[:, :, 0, :, None] + top_s[:, :, 1, None, :]).reshape(T, PEER_HEADS, K * K)
    cand_i = (top_i[:, :, 0, :, None] * PEER_N_KEYS + top_i[:, :, 1, None, :]).reshape(T, PEER_HEADS, K * K)
    best_s, best_pos = lax.top_k(cand_s, K)
    expert_idx = jnp.take_along_axis(cand_i, best_pos, axis=-1)
    gates = jax.nn.softmax(best_s, axis=-1)
    nc = T // PEER_CHUNK

    def one_chunk(args):
        xc, ic, gc = args
        u = jnp.take(expert_u, ic, axis=0)
        vv = jnp.take(expert_v, ic, axis=0)
        act = jax.nn.gelu(jnp.einsum('cd,chkd->chk', xc, u, preferred_element_type=jnp.float32),
                          approximate=False)
        coef = (gc * act).astype(xc.dtype)
        return jnp.einsum('chk,chkd->cd', coef, vv)

    y = lax.map(one_chunk, (xt.reshape(nc, PEER_CHUNK, D),
                            expert_idx.reshape(nc, PEER_CHUNK, PEER_HEADS, K),
                            gates.reshape(nc, PEER_CHUNK, PEER_HEADS, K)))
    return y.reshape(B, S, D)


def setup_inputs(seed: int = 0) -> dict:
    key = jax.random.key(seed)
    ks = jax.random.split(key, 20)
    f32 = jnp.float32
    D = D_MODEL

    def nrm(k, shape, scale):
        return jax.random.normal(k, shape, f32) * scale

    def gain(k, shape):
        return 1.0 + 0.02 * jax.random.normal(k, shape, f32)

    return {
        "x": jax.random.normal(ks[0], (BATCH, SEQ, D), f32),
        "p": jax.random.normal(ks[1], (DEPTH, BATCH, SEQ, PLE_DIM), f32),
        "norm_mix_g": gain(ks[2], (DEPTH, D)),
        "w_in": nrm(ks[3], (DEPTH, D, IN_PROJ_W), D ** -0.5),
        "b_forget": jax.random.uniform(ks[4], (DEPTH, FOX_HEADS), f32, 1.0, 4.0),
        "sinks": nrm(ks[5], (DEPTH, SWA_Q_HEADS), 0.5),
        "g_out_a": gain(ks[6], (DEPTH, SWA_Q_W)),
        "g_out_b": gain(ks[7], (DEPTH, FOX_W)),
        "w_out": nrm(ks[8], (DEPTH, MIX_WIDTH, D), MIX_WIDTH ** -0.5),
        "norm_ffn_g": gain(ks[9], (DEPTH, D)),
        "w_query": nrm(ks[10], (DEPTH, D, PEER_HEADS * PEER_QUERY_DIM), D ** -0.5),
        "sub_keys": nrm(ks[11], (DEPTH, 2, PEER_N_KEYS, PEER_HALF), PEER_HALF ** -0.5),
        "expert_u": nrm(ks[12], (DEPTH, PEER_N_EXPERTS, D), D ** -0.5),
        "expert_v": nrm(ks[13], (DEPTH, PEER_N_EXPERTS, D), PEER_HEADS ** -0.5),
        "norm_ple_g": gain(ks[14], (DEPTH, D)),
        "w_ple_gate": nrm(ks[15], (DEPTH, D, D), D ** -0.5),
        "w_ple_proj": nrm(ks[16], (DEPTH, PLE_DIM, D), PLE_DIM ** -0.5),
        "norm_final_g": gain(ks[17], (D,)),
    }


def reference(x, p, norm_mix_g, w_in, b_forget, sinks, g_out_a, g_out_b, w_out,
              norm_ffn_g, w_query, sub_keys, expert_u, expert_v,
              norm_ple_g, w_ple_gate, w_ple_proj, norm_final_g):
    B, S, D = x.shape
    cos, sin = rope_tables(S)
    o1 = SWA_Q_W
    o2 = o1 + SWA_KV_W
    o3 = o2 + SWA_KV_W
    o4 = o3 + FOX_W
    o5 = o4 + FOX_W
    o6 = o5 + FOX_W
    h = x
    for i in range(DEPTH):
        a = rmsnorm(h, norm_mix_g[i])
        proj = a @ w_in[i]
        qa = proj[..., :o1].reshape(B, S, SWA_Q_HEADS, HEAD_DIM)
        ka = proj[..., o1:o2].reshape(B, S, SWA_KV_HEADS, HEAD_DIM)
        va = proj[..., o2:o3].reshape(B, S, SWA_KV_HEADS, HEAD_DIM)
        qf = proj[..., o3:o4].reshape(B, S, FOX_HEADS, HEAD_DIM)
        kf = proj[..., o4:o5].reshape(B, S, FOX_HEADS, HEAD_DIM)
        vf = proj[..., o5:o6].reshape(B, S, FOX_HEADS, HEAD_DIM)
        log_f = jax.nn.log_sigmoid(proj[..., o6:].astype(jnp.float32)
                                   + b_forget[i].astype(jnp.float32))
        qa = apply_rope(qa, cos, sin)
        ka = apply_rope(ka, cos, sin)
        out_a = swa_sink_attention(qa, ka, va, sinks[i]).reshape(B, S, SWA_Q_W)
        out_b = forgetting_attention(qf, kf, vf, log_f).reshape(B, S, FOX_W)
        mixed = jnp.concatenate([rmsnorm(out_a, g_out_a[i]), rmsnorm(out_b, g_out_b[i])], axis=-1)
        h = h + mixed @ w_out[i]
        h = h + peer(rmsnorm(h, norm_ffn_g[i]), w_query[i], sub_keys[i], expert_u[i], expert_v[i])
        gate = jax.nn.sigmoid((rmsnorm(h, norm_ple_g[i]) @ w_ple_gate[i]).astype(jnp.float32))
        h = h + (gate * (p[i] @ w_ple_proj[i]).astype(jnp.float32)).astype(h.dtype)
    return rmsnorm(h, norm_final_g)
```

```cpp
#include <hip/hip_runtime.h>
#include <cmath>
#include <cstdio>
#ifndef CFG_D
#define CFG_D 1024
#define CFG_B 2
#define CFG_S 8192
#endif
namespace nv {
constexpr int D = CFG_D, B = CFG_B, S = CFG_S, T = B * S;
constexpr int HD = 64, INW = 2312, O1 = 512, O2 = 640, O3 = 768, O4 = 1280, O5 = 1792, O6 = 2304;
constexpr int PH = 8, NK = 128, QD = 256, PHALF = 128, TOPK = 16, PLE = 256;
constexpr float EPS = 1e-6f;
#ifdef HOST_TEST
#define NVHD inline
#else
#define NVHD __device__ __forceinline__
#endif
struct RmsRows { const float* x; const float* g; float* out; long width; long n;
  NVHD void operator()(long r) const { const float* xr = x + r * width; float s = 0.f; for (int i = 0; i < width; ++i) s += xr[i] * xr[i];
    const float rs = 1.0f / sqrtf(s / width + EPS); for (int i = 0; i < width; ++i) out[r * width + i] = xr[i] * rs * g[i]; } };
struct Gemm { const float* A; const float* Bm; const float* R; float* C; int M, N, K, lda, ldb, ldc; long n;
  NVHD void operator()(long i) const { const int m = (int)(i / N), c = (int)(i % N); float s = 0.f; for (int k = 0; k < K; ++k) s += A[(long)m * lda + k] * Bm[(long)k * ldb + c];
    C[(long)m * ldc + c] = (R ? R[(long)m * ldc + c] : 0.f) + s; } };
struct Rope { float* proj; long n;
  NVHD void operator()(long i) const { const int d = (int)(i % 32), j = (int)((i / 32) % 10); const long t = i / 320; const int pos = (int)(t % S);
    const int col = (j < 8) ? j * 64 : O1 + (j - 8) * 64; float* p = proj + t * INW + col;
    const double inv = pow(10000.0, -(double)(2 * d) / 64.0); const double ang = (double)pos * inv; const float cs = (float)cos(ang), sn = (float)sin(ang);
    const float a = p[d], b = p[d + 32]; p[d] = a * cs - b * sn; p[d + 32] = b * cs + a * sn; } };
struct LogF { const float* proj; const float* bf; float* logf; long n;
  NVHD void operator()(long i) const { const int h = (int)(i % 8); const long t = i / 8; const float z = proj[t * INW + O6 + h] + bf[h];
    logf[i] = fminf(z, 0.f) - log1pf(expf(-fabsf(z))); } };
struct CumSum { const float* logf; float* c; long n;
  NVHD void operator()(long i) const { const int h = (int)(i % 8), b = (int)(i / 8); float acc = 0.f; for (int s = 0; s < S; ++s) { acc += logf[((long)b * S + s) * 8 + h]; c[((long)b * S + s) * 8 + h] = acc; } } };
struct Swa { const float* proj; const float* sinks; float* out; long n;
  NVHD void operator()(long i) const { const int hq = (int)(i % 8); const long t = i / 8; const int b = (int)(t / S), pos = (int)(t % S), hkv = hq / 4;
    const float* q = proj + t * INW + hq * 64; float m = sinks[hq], l = 0.f, o[64]; _Pragma("unroll") for (int d = 0; d < 64; ++d) o[d] = 0.f;
    const int s0 = pos - 127 < 0 ? 0 : pos - 127;
    for (int s = s0; s <= pos; ++s) { const float* k = proj + ((long)b * S + s) * INW + O1 + hkv * 64; float dt = 0.f; _Pragma("unroll") for (int d = 0; d < 64; ++d) dt += q[d] * k[d]; dt *= 0.125f; m = fmaxf(m, dt); }
    for (int s = s0; s <= pos; ++s) { const float* k = proj + ((long)b * S + s) * INW + O1 + hkv * 64; const float* v = proj + ((long)b * S + s) * INW + O2 + hkv * 64;
      float dt = 0.f; _Pragma("unroll") for (int d = 0; d < 64; ++d) dt += q[d] * k[d]; dt *= 0.125f; const float e = expf(dt - m); l += e; _Pragma("unroll") for (int d = 0; d < 64; ++d) o[d] += e * v[d]; }
    l += expf(sinks[hq] - m); _Pragma("unroll") for (int d = 0; d < 64; ++d) out[t * 1024 + hq * 64 + d] = o[d] / l; } };
struct Fox { const float* proj; const float* c; float* out; long n;
  NVHD void operator()(long i) const { const int h = (int)(i % 8); const long t = i / 8; const int b = (int)(t / S), pos = (int)(t % S);
    const float* q = proj + t * INW + O3 + h * 64; const float ct = c[t * 8 + h]; float m = -INFINITY, l = 0.f, o[64]; _Pragma("unroll") for (int d = 0; d < 64; ++d) o[d] = 0.f;
    for (int s = 0; s <= pos; ++s) { const long ts = (long)b * S + s; const float* k = proj + ts * INW + O4 + h * 64; const float* v = proj + ts * INW + O5 + h * 64;
      float dt = 0.f; _Pragma("unroll") for (int d = 0; d < 64; ++d) dt += q[d] * k[d]; dt = dt * 0.125f + ct - c[ts * 8 + h];
      if (dt > m) { const float f = expf(m - dt); l *= f; _Pragma("unroll") for (int d = 0; d < 64; ++d) o[d] *= f; m = dt; }
      const float e = expf(dt - m); l += e; _Pragma("unroll") for (int d = 0; d < 64; ++d) o[d] += e * v[d]; }
    _Pragma("unroll") for (int d = 0; d < 64; ++d) out[t * 1024 + 512 + h * 64 + d] = o[d] / l; } };
struct MixNorm { const float* att; const float* ga; const float* gb; float* mixed; long n;
  NVHD void operator()(long i) const { const int grp = (int)(i % 2); const long t = i / 2; const float* a = att + t * 1024 + grp * 512; const float* g = grp ? gb : ga; float s = 0.f; for (int j = 0; j < 512; ++j) s += a[j] * a[j];
    const float rs = 1.0f / sqrtf(s / 512.f + EPS); for (int j = 0; j < 512; ++j) mixed[t * 1024 + grp * 512 + j] = a[j] * rs * g[j]; } };
struct Scores { const float* q; const float* sk; float* sc; long n;
  NVHD void operator()(long i) const { const int k = (int)(i % 128), c = (int)((i / 128) % 2), h = (int)((i / 256) % 8); const long t = i / 2048; const float* qq = q + t * 2048 + h * 256 + c * 128; const float* kk = sk + ((long)c * 128 + k) * 128;
    float s = 0.f; for (int d = 0; d < 128; ++d) s += qq[d] * kk[d]; sc[i] = s; } };
struct TopK { const float* sc; int* idx; float* gate; float* tsv; int* tiv; long n;
  NVHD void operator()(long i) const {
    for (int c = 0; c < 2; ++c) { const float* s = sc + i * 256 + c * 128; float pv = INFINITY; int pi = -1;
      for (int r = 0; r < 16; ++r) { float best = -INFINITY; int bi = -1;
        for (int k = 0; k < 128; ++k) { const float v = s[k]; const bool elig = (v < pv) || (v == pv && k > pi); if (elig && (bi < 0 || v > best)) { best = v; bi = k; } }
        tsv[i * 32 + c * 16 + r] = best; tiv[i * 32 + c * 16 + r] = bi; pv = best; pi = bi; } }
    float pv = INFINITY; int pp = -1;
    for (int r = 0; r < 16; ++r) { float best = -INFINITY; int bp = -1;
      for (int p = 0; p < 256; ++p) { const float v = tsv[i * 32 + (p >> 4)] + tsv[i * 32 + 16 + (p & 15)]; const bool elig = (v < pv) || (v == pv && p > pp); if (elig && (bp < 0 || v > best)) { best = v; bp = p; } }
      gate[i * 16 + r] = best; idx[i * 16 + r] = tiv[i * 32 + (bp >> 4)] * 128 + tiv[i * 32 + 16 + (bp & 15)]; pv = best; pp = bp; }
    const float m0 = gate[i * 16]; float sum = 0.f; for (int r = 0; r < 16; ++r) sum += expf(gate[i * 16 + r] - m0);
    for (int r = 0; r < 16; ++r) gate[i * 16 + r] = expf(gate[i * 16 + r] - m0) / sum; } };
struct FoldW { const float* wq; const float* sk; float* weff; long n;
  NVHD void operator()(long i) const { const int col = (int)(i % 2048); const long j = i / 2048; const int k = col % 128, c = (col / 128) % 2, h = col / 256; const float* a = wq + j * 2048 + h * 256 + c * 128; const float* b = sk + ((long)c * 128 + k) * 128;
    float s = 0.f; for (int d = 0; d < 128; ++d) s += a[d] * b[d]; weff[i] = s; } };
struct PeerAct { const float* xn; const float* U; const int* idx; const float* gate; float* coef; long n;
  NVHD void operator()(long i) const { const long t = i / 128; const float* x = xn + t * D; const float* u = U + (long)idx[i] * D; float s = 0.f; for (int d = 0; d < D; d += 4) s += (x[d] * u[d] + x[d + 1] * u[d + 1]) + (x[d + 2] * u[d + 2] + x[d + 3] * u[d + 3]);
    coef[i] = gate[i] * 0.5f * s * (1.0f + erff(s * 0.70710678118654752f)); } };
struct PeerOut { const float* h1; const float* V; const int* idx; const float* coef; float* h2; long n;
  NVHD void operator()(long i) const { const long t = i / D; const int d = (int)(i % D); float s = 0.f; for (int j = 0; j < 128; ++j) s += coef[t * 128 + j] * V[(long)idx[t * 128 + j] * D + d]; h2[i] = h1[i] + s; } };
struct PleMix { const float* h2; const float* gpre; const float* ple; float* h3; long n;
  NVHD void operator()(long i) const { h3[i] = h2[i] + ple[i] / (1.0f + expf(-gpre[i])); } };
}
template <class F> __global__ void __launch_bounds__(256) run_items(F f) { for (long i = (long)blockIdx.x * 256 + threadIdx.x; i < f.n; i += (long)gridDim.x * 256) f(i); }
template <class F> static void go(const F& f, hipStream_t st) { long nb = (f.n + 255) / 256; if (nb > 262144) nb = 262144; if (nb < 1) nb = 1; hipLaunchKernelGGL(run_items<F>, dim3((unsigned)nb), dim3(256), 0, st, f); }
extern "C" void kernel_launch(void* const* d_in, const int* in_sizes, int n_in, void* d_out, int out_size, void* d_ws, size_t ws_size, hipStream_t stream) {
  using namespace nv;
  const float *x = (const float*)d_in[0], *p = (const float*)d_in[1], *g_mix = (const float*)d_in[2], *w_in = (const float*)d_in[3], *bfg = (const float*)d_in[4], *sinks = (const float*)d_in[5], *ga = (const float*)d_in[6], *gb = (const float*)d_in[7],
              *w_out = (const float*)d_in[8], *g_ffn = (const float*)d_in[9], *w_q = (const float*)d_in[10], *subk = (const float*)d_in[11], *eu = (const float*)d_in[12], *ev = (const float*)d_in[13], *g_ple = (const float*)d_in[14], *w_pg = (const float*)d_in[15],
              *w_pp = (const float*)d_in[16], *g_fin = (const float*)d_in[17];
  float* out = (float*)d_out; char* ws = (char*)d_ws; const size_t MB = 1u << 20;
  if (ws_size < 256 * MB) { fprintf(stderr, "ws too small: %zu\n", ws_size); return; }
  float* A = (float*)(ws + 0 * MB);
  float* proj = (float*)(ws + 64 * MB);
  float* logf = (float*)(ws + 216 * MB); float* c = (float*)(ws + 217 * MB);
  float* att = out; float* mixed = A; float* h1 = out;
  float* xn = (float*)(ws + 128 * MB); float* weff = (float*)(ws + 192 * MB); float* sc = (float*)(ws + 0 * MB);
  float* tsv = (float*)(ws + 200 * MB); float* coef = (float*)(ws + 216 * MB); float* gate = (float*)(ws + 224 * MB); int* idx = (int*)(ws + 232 * MB); int* tiv = (int*)(ws + 240 * MB);
  float* h2 = (float*)(ws + 0 * MB); float* xn2 = (float*)(ws + 64 * MB); float* gpre = (float*)(ws + 128 * MB); float* ple = (float*)(ws + 192 * MB);
  go(RmsRows{x, g_mix, A, D, T}, stream);
  go(Gemm{A, w_in, nullptr, proj, T, INW, D, D, INW, INW, (long)T * INW}, stream);
  go(LogF{proj, bfg, logf, (long)T * 8}, stream);
  go(Rope{proj, (long)T * 320}, stream);
  go(CumSum{logf, c, B * 8}, stream);
  go(Swa{proj, sinks, att, (long)T * 8}, stream);
  go(Fox{proj, c, att, (long)T * 8}, stream);
  go(MixNorm{att, ga, gb, mixed, (long)T * 2}, stream);
  go(Gemm{mixed, w_out, x, h1, T, D, 1024, 1024, D, D, (long)T * D}, stream);
  go(RmsRows{h1, g_ffn, xn, D, T}, stream);
  go(FoldW{w_q, subk, weff, (long)D * 2048}, stream);
  go(Gemm{xn, weff, nullptr, sc, T, 2048, D, D, 2048, 2048, (long)T * 2048}, stream);
  go(TopK{sc, idx, gate, tsv, tiv, (long)T * 8}, stream);
  go(PeerAct{xn, eu, idx, gate, coef, (long)T * 128}, stream);
  go(PeerOut{h1, ev, idx, coef, h2, (long)T * D}, stream);
  go(RmsRows{h2, g_ple, xn2, D, T}, stream);
  go(Gemm{xn2, w_pg, nullptr, gpre, T, D, D, D, D, D, (long)T * D}, stream);
  go(Gemm{p, w_pp, nullptr, ple, T, D, PLE, PLE, D, D, (long)T * D}, stream);
  go(PleMix{h2, gpre, ple, h2, (long)T * D}, stream);
  go(RmsRows{h2, g_fin, out, D, T}, stream);
}
```

```cpp
#include <hip/hip_runtime.h>
#include <hip/hip_bf16.h>
#include <cstdio>
#include <cstdint>
#include <cmath>
__device__ __forceinline__ int mk_lane() { int l; asm volatile("v_mbcnt_lo_u32_b32 %0, -1, 0\n\tv_mbcnt_hi_u32_b32 %0, -1, %0" : "=v"(l)); return l; }
namespace pg8 {
#define PG8_LAS __attribute__((address_space(3)))
typedef unsigned short bf16_t;
typedef short bf16x8 __attribute__((ext_vector_type(8)));
typedef float f32x4 __attribute__((ext_vector_type(4)));
typedef unsigned u32x4 __attribute__((ext_vector_type(4)));
constexpr int BM = 256, BK = 64, HALF = 128, HTB = HALF * BK * 2  , STAGE_BYTES = 8 * HTB, NXCD = 8, WGM = 8;

__host__ __device__ __forceinline__ int lds_byte(int r, int c) { const int st = (r >> 4) * 2 + (c >> 5), rr = r & 15, cc = c & 31, ob = rr * 64 + cc * 2; return st * 1024 + (ob ^ (((ob >> 9) & 1) << 5)); }
__host__ __device__ __forceinline__ void stage_rc(int b, int& R, int& C) { const int st = b / 1024, sb = b % 1024, swz = sb ^ (((sb >> 9) & 1) << 5); R = (st >> 1) * 16 + swz / 64; C = (st & 1) * 32 + (swz % 64) / 2; }
__host__ __device__ __forceinline__ int perm32(int rho) { const int n = rho >> 4, i = rho & 15; return 8 * (i >> 2) + 4 * n + (i & 3); }

struct Unit { int pm, pn; };
struct Gemm { const bf16_t* A; const bf16_t* Bt; int M, N, K; };

struct StaticOrder {
    int nM, nN, nwg, G, c;
    __host__ __device__ void init(int M, int N, int G_, int c_) { nM = M / BM; nN = N / BM; nwg = nM * nN; G = G_; c = c_; }
    __host__ __device__ bool next(int i, Unit& u) const {
        const long L = (long)i * G + c; if (L >= nwg) return false;
        int wgid = (int)L; { const int q = nwg / NXCD, r = nwg % NXCD, xcd = wgid % NXCD, off = wgid / NXCD; wgid = (xcd < r ? xcd * (q + 1) : r * (q + 1) + (xcd - r) * q) + off; }
        const int nig = WGM * nN, gid = wgid / nig, fm = gid * WGM, gsz = (nM - fm) < WGM ? (nM - fm) : WGM;
        u.pm = fm + ((wgid % nig) % gsz); u.pn = (wgid % nig) / gsz; return true;
    }
    __device__ __forceinline__ void a_ready(const Unit&) const {}
    __device__ __forceinline__ void done(const Unit&) const {}
};

__device__ __forceinline__ unsigned cvt_pk_bf16(float lo, float hi) { unsigned r; asm volatile("v_cvt_pk_bf16_f32 %0, %1, %2" : "=v"(r) : "v"(lo), "v"(hi)); return r; }
typedef float f32x2 __attribute__((ext_vector_type(2)));
typedef unsigned u32x2 __attribute__((ext_vector_type(2)));
constexpr float QK_C2 = 0.125f * 1.4426950408889634f;
struct EpiBf16 {
    static constexpr bool PERM = true, AFTER_DRAIN = false, MIDSCALE = false;
    bf16_t* O; int ldc;
    __device__ __forceinline__ void operator()(const f32x4 (&acc)[2][2][4][2], const Unit& u, int wr, int wc, int fr, int fq) const {
        const int row0 = u.pm * BM + wr * 64 + fr, col0 = u.pn * BM + wc * 32 + 8 * fq;
#pragma unroll
        for (int ai = 0; ai < 2; ++ai)
#pragma unroll
            for (int m = 0; m < 4; ++m) { bf16_t* rowp = O + (size_t)(row0 + ai * HALF + m * 16) * ldc + col0;
#pragma unroll
                for (int bj = 0; bj < 2; ++bj) { const f32x4 v0 = acc[ai][bj][m][0], v1 = acc[ai][bj][m][1];
                    u32x4 w; w.x = cvt_pk_bf16(v0[0], v0[1]); w.y = cvt_pk_bf16(v0[2], v0[3]); w.z = cvt_pk_bf16(v1[0], v1[1]); w.w = cvt_pk_bf16(v1[2], v1[3]);
                    *(u32x4*)(rowp + bj * HALF) = w; } }
    }
};
struct EpiProj {
    static constexpr bool PERM = true, AFTER_DRAIN = false, MIDSCALE = false;
    bf16_t* O; const float* rope;
    __device__ __forceinline__ void operator()(const f32x4 (&acc)[2][2][4][2], const Unit& u, int wr, int wc, int fr, int fq) const {
        const int row0 = u.pm * BM + wr * 64 + fr, colb = u.pn * BM + wc * 32 + 8 * fq;
#pragma unroll
        for (int bj = 0; bj < 2; ++bj) {
            const int col = colb + bj * HALF; const bool rot = col < 640; const float sc = (col < 512 || (col >= 768 && col < 1280)) ? QK_C2 : 1.0f; const int i0 = (col & 63) >> 1;
#pragma unroll
            for (int ai = 0; ai < 2; ++ai)
#pragma unroll
                for (int m = 0; m < 4; ++m) { const int row = row0 + ai * HALF + m * 16; f32x4 v0 = acc[ai][bj][m][0], v1 = acc[ai][bj][m][1];
                    if (rot) { const f32x4* rp = (const f32x4*)(rope + ((size_t)(row & 8191) * 32 + i0) * 2); const f32x4 c0 = rp[0], c1 = rp[1];
                        const f32x4 a = v0, b = v1;
                        v0[0] = a[0] * c0[0] - a[1] * c0[1]; v0[1] = a[1] * c0[0] + a[0] * c0[1]; v0[2] = a[2] * c0[2] - a[3] * c0[3]; v0[3] = a[3] * c0[2] + a[2] * c0[3];
                        v1[0] = b[0] * c1[0] - b[1] * c1[1]; v1[1] = b[1] * c1[0] + b[0] * c1[1]; v1[2] = b[2] * c1[2] - b[3] * c1[3]; v1[3] = b[3] * c1[2] + b[2] * c1[3]; }
                    v0 = v0 * sc; v1 = v1 * sc;
                    u32x4 w; w.x = cvt_pk_bf16(v0[0], v0[1]); w.y = cvt_pk_bf16(v0[2], v0[3]); w.z = cvt_pk_bf16(v1[0], v1[1]); w.w = cvt_pk_bf16(v1[2], v1[3]);
                    *(u32x4*)(O + (size_t)row * 2304 + col) = w; }
        }
    }
};
struct PleOrder {
    int c;
    __device__ bool next(int i, Unit& u) const { if (c < 64) return false; const int L = i * 192 + (c - 64); if (L >= 256) return false; u.pm = L >> 2; u.pn = L & 3; return true; }
    __device__ __forceinline__ void a_ready(const Unit&) const {}
    __device__ __forceinline__ void done(const Unit&) const {}
};
struct EpiOut {
    static constexpr bool PERM = false, AFTER_DRAIN = false, MIDSCALE = true;
    const float* x; float* h; bf16_t* hb; const PG8_LAS float* tab; float* ssq1;
    __device__ __forceinline__ void mid(f32x4 (&acc)[2][2][4][2], const Unit& u, int wr, int wc, int fr, int fq) const {
#pragma unroll
        for (int ai = 0; ai < 2; ++ai)
#pragma unroll
            for (int m = 0; m < 4; ++m) { const float ratio = tab[ai * HALF + wr * 64 + m * 16 + fr];
#pragma unroll
                for (int bj = 0; bj < 2; ++bj)
#pragma unroll
                    for (int n = 0; n < 2; ++n) acc[ai][bj][m][n] = acc[ai][bj][m][n] * ratio; }
    }
    __device__ __forceinline__ void operator()(const f32x4 (&acc)[2][2][4][2], const Unit& u, int wr, int wc, int fr, int fq) const {
        const int col0 = u.pn * BM + wc * 32 + 4 * fq;
#pragma unroll
        for (int ai = 0; ai < 2; ++ai)
#pragma unroll
            for (int m = 0; m < 4; ++m) { const int tr = ai * HALF + wr * 64 + m * 16 + fr, row = u.pm * BM + tr; const float rb = tab[256 + tr]; const size_t off = (size_t)row * 1024 + col0; float q = 0.f;
#pragma unroll
                for (int bj = 0; bj < 2; ++bj)
#pragma unroll
                    for (int n = 0; n < 2; ++n) { const f32x4 v = *(const f32x4*)(x + off + bj * HALF + n * 16) + acc[ai][bj][m][n] * rb;
                        *(f32x4*)(h + off + bj * HALF + n * 16) = v; u32x2 w; w.x = cvt_pk_bf16(v[0], v[1]); w.y = cvt_pk_bf16(v[2], v[3]); *(u32x2*)(hb + off + bj * HALF + n * 16) = w;
                        q += (v[0] * v[0] + v[1] * v[1]) + (v[2] * v[2] + v[3] * v[3]); }
                q += __shfl_xor(q, 16); q += __shfl_xor(q, 32); if (fq == 0) unsafeAtomicAdd(ssq1 + row, q); }
    }
};
struct EpiPle {
    static constexpr bool PERM = false, AFTER_DRAIN = false, MIDSCALE = false;
    float* h; const bf16_t* ple; const float* ssq2; float* ssq3;
    __device__ __forceinline__ void operator()(const f32x4 (&acc)[2][2][4][2], const Unit& u, int wr, int wc, int fr, int fq) const {
        const int col0 = u.pn * BM + wc * 32 + 4 * fq;
#pragma unroll
        for (int ai = 0; ai < 2; ++ai)
#pragma unroll
            for (int m = 0; m < 4; ++m) { const int row = u.pm * BM + ai * HALF + wr * 64 + m * 16 + fr; const float r2 = 1.0f / sqrtf(ssq2[row] * (1.f / 1024.f) + 1e-6f); const size_t off = (size_t)row * 1024 + col0; float q = 0.f;
#pragma unroll
                for (int bj = 0; bj < 2; ++bj)
#pragma unroll
                    for (int n = 0; n < 2; ++n) { const size_t o2 = off + bj * HALF + n * 16; const f32x4 a = acc[ai][bj][m][n] * r2; const u32x2 pw = *(const u32x2*)(ple + o2); f32x4 v = *(const f32x4*)(h + o2);
                        v[0] += __uint_as_float(pw.x << 16) / (1.0f + __expf(-a[0])); v[1] += __uint_as_float(pw.x & 0xffff0000u) / (1.0f + __expf(-a[1]));
                        v[2] += __uint_as_float(pw.y << 16) / (1.0f + __expf(-a[2])); v[3] += __uint_as_float(pw.y & 0xffff0000u) / (1.0f + __expf(-a[3]));
                        *(f32x4*)(h + o2) = v; q += (v[0] * v[0] + v[1] * v[1]) + (v[2] * v[2] + v[3] * v[3]); }
                q += __shfl_xor(q, 16); q += __shfl_xor(q, 32); if (fq == 0) unsafeAtomicAdd(ssq3 + row, q); }
    }
};
#define TK_CE(a,b) { const float hi_=__builtin_fmaxf(a,b), lo_=__builtin_fminf(a,b); a=hi_; b=lo_; }
__device__ __forceinline__ void tk_sort16(float (&x)[16]) {
  TK_CE(x[0],x[1])
  TK_CE(x[2],x[3])
  TK_CE(x[0],x[2])
  TK_CE(x[1],x[3])
  TK_CE(x[1],x[2])
  TK_CE(x[4],x[5])
  TK_CE(x[6],x[7])
  TK_CE(x[4],x[6])
  TK_CE(x[5],x[7])
  TK_CE(x[5],x[6])
  TK_CE(x[0],x[4])
  TK_CE(x[2],x[6])
  TK_CE(x[2],x[4])
  TK_CE(x[1],x[5])
  TK_CE(x[3],x[7])
  TK_CE(x[3],x[5])
  TK_CE(x[1],x[2])
  TK_CE(x[3],x[4])
  TK_CE(x[5],x[6])
  TK_CE(x[8],x[9])
  TK_CE(x[10],x[11])
  TK_CE(x[8],x[10])
  TK_CE(x[9],x[11])
  TK_CE(x[9],x[10])
  TK_CE(x[12],x[13])
  TK_CE(x[14],x[15])
  TK_CE(x[12],x[14])
  TK_CE(x[13],x[15])
  TK_CE(x[13],x[14])
  TK_CE(x[8],x[12])
  TK_CE(x[10],x[14])
  TK_CE(x[10],x[12])
  TK_CE(x[9],x[13])
  TK_CE(x[11],x[15])
  TK_CE(x[11],x[13])
  TK_CE(x[9],x[10])
  TK_CE(x[11],x[12])
  TK_CE(x[13],x[14])
  TK_CE(x[0],x[8])
  TK_CE(x[4],x[12])
  TK_CE(x[4],x[8])
  TK_CE(x[2],x[10])
  TK_CE(x[6],x[14])
  TK_CE(x[6],x[10])
  TK_CE(x[2],x[4])
  TK_CE(x[6],x[8])
  TK_CE(x[10],x[12])
  TK_CE(x[1],x[9])
  TK_CE(x[5],x[13])
  TK_CE(x[5],x[9])
  TK_CE(x[3],x[11])
  TK_CE(x[7],x[15])
  TK_CE(x[7],x[11])
  TK_CE(x[3],x[5])
  TK_CE(x[7],x[9])
  TK_CE(x[11],x[13])
  TK_CE(x[1],x[2])
  TK_CE(x[3],x[4])
  TK_CE(x[5],x[6])
  TK_CE(x[7],x[8])
  TK_CE(x[9],x[10])
  TK_CE(x[11],x[12])
  TK_CE(x[13],x[14])
}
__device__ __forceinline__ void tk_clean16(float (&x)[16]) {
  TK_CE(x[0],x[8])
  TK_CE(x[1],x[9])
  TK_CE(x[2],x[10])
  TK_CE(x[3],x[11])
  TK_CE(x[4],x[12])
  TK_CE(x[5],x[13])
  TK_CE(x[6],x[14])
  TK_CE(x[7],x[15])
  TK_CE(x[0],x[4])
  TK_CE(x[1],x[5])
  TK_CE(x[2],x[6])
  TK_CE(x[3],x[7])
  TK_CE(x[8],x[12])
  TK_CE(x[9],x[13])
  TK_CE(x[10],x[14])
  TK_CE(x[11],x[15])
  TK_CE(x[0],x[2])
  TK_CE(x[1],x[3])
  TK_CE(x[4],x[6])
  TK_CE(x[5],x[7])
  TK_CE(x[8],x[10])
  TK_CE(x[9],x[11])
  TK_CE(x[12],x[14])
  TK_CE(x[13],x[15])
  TK_CE(x[0],x[1])
  TK_CE(x[2],x[3])
  TK_CE(x[4],x[5])
  TK_CE(x[6],x[7])
  TK_CE(x[8],x[9])
  TK_CE(x[10],x[11])
  TK_CE(x[12],x[13])
  TK_CE(x[14],x[15])
}
__device__ __forceinline__ void tk_merge16(float (&a)[16], const float (&b)[16]) {
#pragma unroll
  for (int i = 0; i < 16; ++i) a[i] = __builtin_fmaxf(a[i], b[15 - i]);
  tk_clean16(a);
}
#define TK_NPAIR 50
#define TK_PAIRS(X) X(0,0,0) X(1,0,1) X(2,0,2) X(3,0,3) X(4,0,4) X(5,0,5) X(6,0,6) X(7,0,7) X(8,0,8) X(9,0,9) X(10,0,10) X(11,0,11) X(12,0,12) X(13,0,13) X(14,0,14) X(15,0,15) X(16,1,0) X(17,1,1) X(18,1,2) X(19,1,3) X(20,1,4) X(21,1,5) X(22,1,6) X(23,1,7) X(24,2,0) X(25,2,1) X(26,2,2) X(27,2,3) X(28,2,4) X(29,3,0) X(30,3,1) X(31,3,2) X(32,3,3) X(33,4,0) X(34,4,1) X(35,4,2) X(36,5,0) X(37,5,1) X(38,6,0) X(39,6,1) X(40,7,0) X(41,7,1) X(42,8,0) X(43,9,0) X(44,10,0) X(45,11,0) X(46,12,0) X(47,13,0) X(48,14,0) X(49,15,0)
struct EpiTopK {
    static constexpr bool PERM = false, AFTER_DRAIN = true, MIDSCALE = false;
    const float* ssq1; unsigned short* idx; float* gate;
    __device__ __forceinline__ void fused(f32x4 (&acc)[2][2][4][2], const Unit& u, int wr, int wc, int fr, int fq, PG8_LAS unsigned char* lds, int wid, int lane) const {
        constexpr int TP = 260;
        PG8_LAS float* T = (PG8_LAS float*)lds;
        PG8_LAS float* L1 = (PG8_LAS float*)lds;
        PG8_LAS float* MG = (PG8_LAS float*)(lds + 32768);
        PG8_LAS unsigned char* PT = (PG8_LAS unsigned char*)(lds + 49152);
        const int tid = wid * 64 + lane;
#pragma unroll 1
        for (int ai = 0; ai < 2; ++ai) {
#pragma unroll
            for (int m = 0; m < 4; ++m)
#pragma unroll
                for (int bj = 0; bj < 2; ++bj)
#pragma unroll
                    for (int n = 0; n < 2; ++n) { const f32x4 v = ai == 0 ? acc[0][bj][m][n] : acc[1][bj][m][n]; *(PG8_LAS f32x4*)(T + (wr * 64 + m * 16 + fr) * TP + bj * 128 + wc * 32 + n * 16 + 4 * fq) = v; }
            asm volatile("s_waitcnt lgkmcnt(0)" ::: "memory"); __builtin_amdgcn_s_barrier(); asm volatile("" ::: "memory");
            float x[4][16];
            { const int row = tid & 127, cq = tid >> 7; const PG8_LAS f32x4* src = (const PG8_LAS f32x4*)(T + row * TP + cq * 64);
#pragma unroll
              for (int g = 0; g < 4; ++g)
#pragma unroll
                  for (int e = 0; e < 4; ++e) { const f32x4 v = src[g * 4 + e];
#pragma unroll
                      for (int j = 0; j < 4; ++j) x[g][e * 4 + j] = __uint_as_float((__float_as_uint(v[j]) & ~127u) | (unsigned)((cq & 1) * 64 + g * 16 + e * 4 + j)); } }
            asm volatile("s_waitcnt lgkmcnt(0)" ::: "memory"); __builtin_amdgcn_s_barrier(); asm volatile("" ::: "memory");
            tk_sort16(x[0]); tk_sort16(x[1]); tk_sort16(x[2]); tk_sort16(x[3]);
            tk_merge16(x[0], x[1]); tk_merge16(x[2], x[3]); tk_merge16(x[0], x[2]);
            { PG8_LAS f32x4* dst = (PG8_LAS f32x4*)(L1 + ((tid & 127) * 4 + (tid >> 7)) * 16);
#pragma unroll
              for (int e = 0; e < 4; ++e) dst[e] = (f32x4){x[0][4 * e], x[0][4 * e + 1], x[0][4 * e + 2], x[0][4 * e + 3]}; }
            if (tid < 64) { unsigned char v = 0;
#define TK_PT(p, i, j) if (tid == p) v = (unsigned char)(i | (j << 4));
                TK_PAIRS(TK_PT)
#undef TK_PT
                PT[tid] = v; }
            asm volatile("s_waitcnt lgkmcnt(0)" ::: "memory"); __builtin_amdgcn_s_barrier(); asm volatile("" ::: "memory");
            if (tid < 128) {
                const int row = tid; const int grow = u.pm * BM + ai * HALF + row;
                float a[16], b[16], t2[16];
                { const PG8_LAS f32x4* s0 = (const PG8_LAS f32x4*)(L1 + (row * 4 + 0) * 16);
#pragma unroll
                  for (int e = 0; e < 4; ++e) { const f32x4 v0 = s0[e], v1 = s0[4 + e], v2 = s0[8 + e], v3 = s0[12 + e];
#pragma unroll
                      for (int j = 0; j < 4; ++j) { a[4 * e + j] = v0[j]; t2[4 * e + j] = v1[j]; b[4 * e + j] = v2[j]; x[3][4 * e + j] = v3[j]; } } }
                tk_merge16(a, t2); tk_merge16(b, x[3]);
                { PG8_LAS f32x4* d = (PG8_LAS f32x4*)(MG + row * 32);
#pragma unroll
                  for (int e = 0; e < 4; ++e) { d[e] = (f32x4){a[4 * e], a[4 * e + 1], a[4 * e + 2], a[4 * e + 3]}; d[4 + e] = (f32x4){b[4 * e], b[4 * e + 1], b[4 * e + 2], b[4 * e + 3]}; } }
#pragma unroll
                for (int g = 0; g < 4; ++g)
#pragma unroll
                    for (int e = 0; e < 16; ++e) x[g][e] = __uint_as_float(0xff000000u | (unsigned)(g * 16 + e));
#define TK_CAND(p, i, j) x[(p) >> 4][(p) & 15] = __uint_as_float((__float_as_uint(a[i] + b[j]) & ~63u) | (unsigned)(p));
                TK_PAIRS(TK_CAND)
#undef TK_CAND
                tk_sort16(x[0]); tk_sort16(x[1]); tk_sort16(x[2]); tk_sort16(x[3]);
                tk_merge16(x[0], x[1]); tk_merge16(x[2], x[3]); tk_merge16(x[0], x[2]);
                const float rs = 1.0f / sqrtf(ssq1[grow] * (1.f / 1024.f) + 1e-6f);
                float ex[16], sum = 0.f;
#pragma unroll
                for (int r = 0; r < 16; ++r) { ex[r] = __expf((x[0][r] - x[0][0]) * rs); sum += ex[r]; }
                const float inv = 1.0f / sum;
                asm volatile("s_waitcnt lgkmcnt(0)" ::: "memory");
                unsigned short* ip = idx + (size_t)grow * 128 + u.pn * 16; float* gp = gate + (size_t)grow * 128 + u.pn * 16;
                unsigned ew[8];
#pragma unroll
                for (int r = 0; r < 16; ++r) { const unsigned pid = __float_as_uint(x[0][r]) & 63u; const unsigned ij = PT[pid];
                    const unsigned ka = __float_as_uint(MG[row * 32 + (ij & 15u)]) & 127u, kb = __float_as_uint(MG[row * 32 + 16 + (ij >> 4)]) & 127u; const unsigned e = ka * 128u + kb;
                    if (r & 1) ew[r >> 1] |= e << 16; else ew[r >> 1] = e; }
                *(u32x4*)ip = (u32x4){ew[0], ew[1], ew[2], ew[3]}; *(u32x4*)(ip + 8) = (u32x4){ew[4], ew[5], ew[6], ew[7]};
#pragma unroll
                for (int e = 0; e < 4; ++e) *(f32x4*)(gp + 4 * e) = (f32x4){ex[4 * e] * inv, ex[4 * e + 1] * inv, ex[4 * e + 2] * inv, ex[4 * e + 3] * inv};
            }
            asm volatile("s_waitcnt lgkmcnt(0)" ::: "memory"); __builtin_amdgcn_s_barrier(); asm volatile("" ::: "memory");
        }
    }
};
struct RoundOrder {
    StaticOrder so; int round;
    __device__ bool next(int i, Unit& u) const { return i == 0 && so.next(round, u); }
    __device__ __forceinline__ void a_ready(const Unit&) const {}
    __device__ __forceinline__ void done(const Unit&) const {}
};
template <class Epi, class Sched, bool ALIGN_EPI = false, bool SP2 = false>
__device__ __forceinline__ void gemm_phase(PG8_LAS unsigned char* lds, const Gemm g, const Sched& S, const Epi& E, const int MKW) {
    const int wid = MKW, lane = mk_lane(), tid = wid * 64 + lane, wr = wid >> 2, wc = wid & 3, fr = lane & 15, fq = lane >> 4;
    const int K = g.K, nt = K / BK;
    unsigned voffA[2], voffB[2];
#pragma unroll
    for (int i = 0; i < 2; ++i) { int R, C; stage_rc(tid * 16 + i * 8192, R, C); const int Rb = Epi::PERM ? ((R & ~31) + perm32(R & 31)) : R;
        voffA[i] = (unsigned)(R * K + C) * 2u; voffB[i] = (unsigned)(Rb * K + C) * 2u; }
    const size_t kstep = (size_t)(BK * 2);
    const size_t hstep = (size_t)HALF * K * 2;
    const size_t tstep = 2 * hstep;
    const unsigned ldsw = (unsigned)wid * 1024u;
    const int aoff = lds_byte(wr * 64 + fr, fq * 8), boff = lds_byte(wc * 32 + fr, fq * 8);
#define PG8_SA(b, h) (((b) * 2 + (h)) * HTB)
#define PG8_SB(b, h) ((4 + (b) * 2 + (h)) * HTB)
#define PG8_STAGE(bufoff, gbase, voff) do { _Pragma("unroll") for (int _i = 0; _i < 2; ++_i) \
        __builtin_amdgcn_global_load_lds((const unsigned*)((const char*)(gbase) + (voff)[_i]), (PG8_LAS unsigned*)(lds + (bufoff) + ldsw + _i * 8192), 16, 0, 0); } while (0)
#define PG8_LDA(dst, b, h) do { _Pragma("unroll") for (int m = 0; m < 4; ++m) _Pragma("unroll") for (int k = 0; k < 2; ++k) dst[m][k] = *(const PG8_LAS bf16x8*)(lds + PG8_SA(b, h) + aoff + m * 2048 + k * 1024); } while (0)
#define PG8_LDB(dst, b, h) do { _Pragma("unroll") for (int n = 0; n < 2; ++n) _Pragma("unroll") for (int k = 0; k < 2; ++k) dst[n][k] = *(const PG8_LAS bf16x8*)(lds + PG8_SB(b, h) + boff + n * 2048 + k * 1024); } while (0)
#define PG8_MMA(ai, bj, At, Bt) do { __builtin_amdgcn_s_setprio(1); _Pragma("unroll") for (int m = 0; m < 4; ++m) _Pragma("unroll") for (int n = 0; n < 2; ++n) _Pragma("unroll") for (int k = 0; k < 2; ++k) \
        acc[ai][bj][m][n] = __builtin_amdgcn_mfma_f32_16x16x32_bf16(Bt[n][k], At[m][k], acc[ai][bj][m][n], 0, 0, 0); __builtin_amdgcn_s_setprio(0); } while (0)
#define PG8_WAIT_V(n) asm volatile("s_waitcnt vmcnt(" #n ")" ::: "memory")
#define PG8_WAIT_L(n) asm volatile("s_waitcnt lgkmcnt(" #n ")" ::: "memory")
#define PG8_BAR __builtin_amdgcn_s_barrier()
#define PG8_SCHED __builtin_amdgcn_sched_barrier(0)
    Unit cur, nxt; int ui = 0;
    if (!S.next(0, cur)) return;
    f32x4 acc[2][2][4][2];
#pragma unroll
    for (int a = 0; a < 2; ++a)
#pragma unroll
        for (int b = 0; b < 2; ++b)
#pragma unroll
            for (int m = 0; m < 4; ++m)
#pragma unroll
                for (int n = 0; n < 2; ++n) acc[a][b][m][n] = (f32x4){0.f, 0.f, 0.f, 0.f};
    bf16x8 At[4][2], B0[2][2], B1[2][2];
    const char* cA = (const char*)g.A + (size_t)cur.pm * tstep; const char* cB = (const char*)g.Bt + (size_t)cur.pn * tstep;
    S.a_ready(cur);
    if constexpr (SP2) {
        PG8_STAGE(PG8_SB(0, 0), cB, voffB); PG8_STAGE(PG8_SB(0, 1), cB + hstep, voffB); PG8_STAGE(PG8_SA(0, 0), cA, voffA); PG8_STAGE(PG8_SA(0, 1), cA + hstep, voffA);
        if (wr == 1) PG8_BAR;
        PG8_WAIT_V(2); PG8_BAR;
        PG8_STAGE(PG8_SB(1, 0), cB + kstep, voffB); PG8_STAGE(PG8_SA(1, 0), cA + kstep, voffA); PG8_STAGE(PG8_SB(1, 1), cB + hstep + kstep, voffB);
        PG8_WAIT_V(6); PG8_BAR;
    } else {
        PG8_STAGE(PG8_SB(0, 0), cB, voffB); PG8_STAGE(PG8_SA(0, 0), cA, voffA); PG8_STAGE(PG8_SB(0, 1), cB + hstep, voffB); PG8_STAGE(PG8_SA(0, 1), cA + hstep, voffA);
        if (wr == 1) PG8_BAR;
        PG8_WAIT_V(4); PG8_BAR;
        PG8_STAGE(PG8_SB(1, 0), cB + kstep, voffB); PG8_STAGE(PG8_SA(1, 0), cA + kstep, voffA); PG8_STAGE(PG8_SB(1, 1), cB + hstep + kstep, voffB);
        PG8_WAIT_V(6); PG8_BAR;
    }
    for (;;) {
        const bool has_next = S.next(ui + 1, nxt);
        const char* nA = has_next ? (const char*)g.A + (size_t)nxt.pm * tstep : cA; const char* nB = has_next ? (const char*)g.Bt + (size_t)nxt.pn * tstep : cB;
        for (int t = 0; t < nt; t += 2) {
            const bool last = (t == nt - 2);
            if constexpr (Epi::MIDSCALE) { if (t == (nt >> 1)) E.mid(acc, cur, wr, wc, fr, fq); }
            const char* a1 = cA + (size_t)(t + 1) * kstep;
            const char* a2 = last ? nA : cA + (size_t)(t + 2) * kstep; const char* b2 = last ? nB : cB + (size_t)(t + 2) * kstep;
            const char* a3 = a2 + kstep; const char* b3 = b2 + kstep;
            if (last && has_next) S.a_ready(nxt);
            if constexpr (SP2) {
            PG8_LDB(B0, 0, 0); PG8_LDB(B1, 0, 1); PG8_SCHED; PG8_LDA(At, 0, 0); PG8_STAGE(PG8_SA(1, 1), a1 + hstep, voffA);
            PG8_WAIT_V(8); PG8_WAIT_L(0); PG8_BAR; PG8_MMA(0, 0, At, B0); PG8_MMA(0, 1, At, B1); PG8_BAR; PG8_SCHED;
            PG8_LDA(At, 0, 1); PG8_STAGE(PG8_SB(0, 0), b2, voffB); PG8_STAGE(PG8_SB(0, 1), b2 + hstep, voffB); PG8_STAGE(PG8_SA(0, 0), a2, voffA);
            PG8_WAIT_V(8); PG8_WAIT_L(0); PG8_BAR; PG8_MMA(1, 0, At, B0); PG8_MMA(1, 1, At, B1); PG8_BAR; PG8_SCHED;
            PG8_LDB(B0, 1, 0); PG8_LDB(B1, 1, 1); PG8_SCHED; PG8_LDA(At, 1, 0); PG8_STAGE(PG8_SA(0, 1), a2 + hstep, voffA);
            PG8_WAIT_V(8); PG8_WAIT_L(0); PG8_BAR; PG8_MMA(0, 0, At, B0); PG8_MMA(0, 1, At, B1); PG8_BAR; PG8_SCHED;
            PG8_LDA(At, 1, 1); PG8_STAGE(PG8_SB(1, 0), b3, voffB); PG8_STAGE(PG8_SB(1, 1), b3 + hstep, voffB); PG8_STAGE(PG8_SA(1, 0), a3, voffA);
            PG8_WAIT_V(8); PG8_WAIT_L(0); PG8_BAR; PG8_MMA(1, 0, At, B0); PG8_MMA(1, 1, At, B1); PG8_BAR; PG8_SCHED;
            } else {
            PG8_LDB(B0, 0, 0); PG8_SCHED; PG8_LDA(At, 0, 0); PG8_STAGE(PG8_SA(1, 1), a1 + hstep, voffA);
            PG8_WAIT_L(8); PG8_BAR; PG8_WAIT_L(0); PG8_MMA(0, 0, At, B0); PG8_BAR; PG8_SCHED;
            PG8_LDB(B1, 0, 1); PG8_STAGE(PG8_SB(0, 0), b2, voffB);
            PG8_BAR; PG8_WAIT_L(0); PG8_MMA(0, 1, At, B1); PG8_BAR;
            PG8_LDA(At, 0, 1); PG8_STAGE(PG8_SA(0, 0), a2, voffA);
            PG8_BAR; PG8_WAIT_L(0); PG8_MMA(1, 0, At, B0); PG8_BAR; PG8_SCHED;
            PG8_STAGE(PG8_SB(0, 1), b2 + hstep, voffB);
            PG8_WAIT_V(6); PG8_BAR; PG8_MMA(1, 1, At, B1); PG8_BAR;
            PG8_LDB(B0, 1, 0); PG8_SCHED; PG8_LDA(At, 1, 0); PG8_STAGE(PG8_SA(0, 1), a2 + hstep, voffA);
            PG8_WAIT_L(8); PG8_BAR; PG8_WAIT_L(0); PG8_MMA(0, 0, At, B0); PG8_BAR; PG8_SCHED;
            PG8_LDB(B1, 1, 1); PG8_STAGE(PG8_SB(1, 0), b3, voffB);
            PG8_BAR; PG8_WAIT_L(0); PG8_MMA(0, 1, At, B1); PG8_BAR;
            PG8_LDA(At, 1, 1); PG8_STAGE(PG8_SA(1, 0), a3, voffA);
            PG8_BAR; PG8_WAIT_L(0); PG8_MMA(1, 0, At, B0); PG8_BAR; PG8_SCHED;
            PG8_STAGE(PG8_SB(1, 1), b3 + hstep, voffB);
            PG8_WAIT_V(6); PG8_BAR; PG8_MMA(1, 1, At, B1); PG8_BAR;
            }
        }
        if constexpr (ALIGN_EPI) { if (wr == 0) PG8_BAR; }
        if constexpr (!Epi::AFTER_DRAIN) { E(acc, cur, wr, wc, fr, fq); S.done(cur); }
        if (!has_next) break;
#pragma unroll
        for (int a = 0; a < 2; ++a)
#pragma unroll
            for (int b = 0; b < 2; ++b)
#pragma unroll
                for (int m = 0; m < 4; ++m)
#pragma unroll
                    for (int n = 0; n < 2; ++n) acc[a][b][m][n] = (f32x4){0.f, 0.f, 0.f, 0.f};
        cur = nxt; cA = nA; cB = nB; ++ui;
        if constexpr (ALIGN_EPI) { if (wr == 1) PG8_BAR; }
    }
    PG8_WAIT_V(0);
    if constexpr (!ALIGN_EPI) { if (wr == 0) PG8_BAR; }
    PG8_BAR;
    if constexpr (Epi::AFTER_DRAIN) { E.fused(acc, cur, wr, wc, fr, fq, lds, wid, lane); S.done(cur); }
#undef PG8_SA
#undef PG8_SB
#undef PG8_STAGE
#undef PG8_LDA
#undef PG8_LDB
#undef PG8_MMA
#undef PG8_WAIT_V
#undef PG8_WAIT_L
#undef PG8_BAR
#undef PG8_SCHED
}
}
namespace attn_body {
using bf16=__hip_bfloat16;
using bf16x8=__attribute__((ext_vector_type(8)))short;
using s16x4=__attribute__((ext_vector_type(4)))short;
using f32x16=__attribute__((ext_vector_type(16)))float;
using u32x4=__attribute__((ext_vector_type(4)))unsigned;
using f32x4_t=__attribute__((ext_vector_type(4)))float;
constexpr int BATCH=2,NHEAD=8,SEQ=8192,D=64,DMQ=2304,DMO=1024;
constexpr int NW=8,QBLK=32,QB=QBLK*NW,KVBLK=64,NQB=SEQ/QB;
constexpr int ATTN_UNIT_ROWS=QB;
__device__ __forceinline__ int crow(int r,int hi){return (r&3)+8*(r>>2)+4*hi;}
#define SBAR() __builtin_amdgcn_sched_barrier(0)
__device__ __forceinline__ void cmask(f32x16&p0,f32x16&p1,int jb,int qrel,int hi){
  const float NEG=-INFINITY; int kb=64*jb+4*hi;
  #pragma unroll
  for(int r=0;r<16;++r){int kv=kb+(r&3)+8*(r>>2); if(kv>qrel)p0[r]=NEG; if(kv+32>qrel)p1[r]=NEG;}
}

constexpr int NSLOT=3, SLOTB=8192;
constexpr int LDS_K=0, LDS_V=NSLOT*SLOTB, LDS_WS=2*NSLOT*SLOTB, LDS_OST=LDS_WS+NW*64*4, LDS_BYTES=LDS_OST+NW*4096;
constexpr float C2=0.125f*1.4426950408889634f;
__device__ __forceinline__ void glds16(const void*gsrc,unsigned lds_dst){unsigned keep;
  asm volatile("s_mov_b32 %0, m0\n\ts_mov_b32 m0, %2\n\ts_nop 0\n\tglobal_load_lds_dwordx4 %1, off\n\ts_mov_b32 m0, %0":"=&s"(keep):"v"(gsrc),"s"(lds_dst):"memory");}
__device__ __forceinline__ float max3f(float a,float b,float c){float r;asm("v_max3_f32 %0, %1, %2, %3":"=v"(r):"v"(a),"v"(b),"v"(c));return r;}
__device__ __forceinline__ float max2f(float a,float b){float r;asm("v_max_f32_e32 %0, %1, %2":"=v"(r):"v"(a),"v"(b));return r;}
__device__ __forceinline__ float fadd_s(float a,float b){float r;asm("v_add_f32_e32 %0, %1, %2":"=v"(r):"v"(a),"v"(b));return r;}
__device__ __forceinline__ float fsub_s(float a,float b){float r;asm("v_sub_f32_e32 %0, %1, %2":"=v"(r):"v"(a),"v"(b));return r;}
typedef float f32x2_t __attribute__((ext_vector_type(2))); typedef __bf16 bf16x2_t __attribute__((ext_vector_type(2)));
__device__ __forceinline__ unsigned cvtpk_s(float lo,float hi){f32x2_t v={lo,hi};bf16x2_t b=__builtin_convertvector(v,bf16x2_t);return __builtin_bit_cast(unsigned,b);}
#define WAIT_BAR(N) asm volatile("s_waitcnt vmcnt(" #N ") lgkmcnt(0)\n\ts_barrier":::"memory")

__device__ __forceinline__ void qkt(f32x16&p0,f32x16&p1,const char*Kslot,const bf16x8*qr,const f32x16 cin0,const f32x16 cin1,int r32,int hi){
  const char*kb=Kslot+hi*1024+r32*16;
  #pragma unroll
  for(int d0=0;d0<4;++d0){
    const bf16x8 b0=*reinterpret_cast<const bf16x8*>(kb+d0*2048);
    const bf16x8 b1=*reinterpret_cast<const bf16x8*>(kb+d0*2048+512);
    if(d0==0){p0=__builtin_amdgcn_mfma_f32_32x32x16_bf16(b0,qr[0],cin0,0,0,0);p1=__builtin_amdgcn_mfma_f32_32x32x16_bf16(b1,qr[0],cin1,0,0,0);}
    else{p0=__builtin_amdgcn_mfma_f32_32x32x16_bf16(b0,qr[d0],p0,0,0,0);p1=__builtin_amdgcn_mfma_f32_32x32x16_bf16(b1,qr[d0],p1,0,0,0);}}
}
typedef __attribute__((address_space(3))) const char* lds_cptr;
typedef short v4i16_t __attribute__((ext_vector_type(4)));
__device__ __forceinline__ void kload8(bf16x8*kf,lds_cptr kp){
  kf[0]=*(const __attribute__((address_space(3))) bf16x8*)(kp);      kf[1]=*(const __attribute__((address_space(3))) bf16x8*)(kp+512);
  kf[2]=*(const __attribute__((address_space(3))) bf16x8*)(kp+2048); kf[3]=*(const __attribute__((address_space(3))) bf16x8*)(kp+2560);
  kf[4]=*(const __attribute__((address_space(3))) bf16x8*)(kp+4096); kf[5]=*(const __attribute__((address_space(3))) bf16x8*)(kp+4608);
  kf[6]=*(const __attribute__((address_space(3))) bf16x8*)(kp+6144); kf[7]=*(const __attribute__((address_space(3))) bf16x8*)(kp+6656);
}
__device__ __forceinline__ void kload2(bf16x8*kf,lds_cptr kp,int j){ kf[2*j]=*(const __attribute__((address_space(3))) bf16x8*)(kp+j*2048); kf[2*j+1]=*(const __attribute__((address_space(3))) bf16x8*)(kp+j*2048+512); }
__device__ __forceinline__ s16x4 vtr(lds_cptr p){ return __builtin_bit_cast(s16x4,__builtin_amdgcn_ds_read_tr16_b64_v4i16((__attribute__((address_space(3))) v4i16_t*)p)); }
__device__ __forceinline__ float rowmax(const f32x16&p0,const f32x16&p1){
  float a=max3f(p0[0],p0[1],p1[0]),b=max3f(p0[2],p0[3],p1[1]);a=max3f(a,p1[2],p1[3]);
  #pragma unroll
  for(int r=4;r<16;r+=4){a=max3f(a,p0[r],p0[r+1]);b=max3f(b,p0[r+2],p0[r+3]);a=max3f(a,p1[r],p1[r+1]);b=max3f(b,p1[r+2],p1[r+3]);}
  const float m=max2f(a,b);
  auto rr=__builtin_amdgcn_permlane32_swap(__float_as_uint(m),__float_as_uint(m),false,false);
  return max2f(__uint_as_float(rr[0]),__uint_as_float(rr[1]));
}
__device__ __forceinline__ void pv(f32x16*o,int vb,bf16x8 pa0,bf16x8 pa1,bf16x8 pa2,bf16x8 pa3){
  #pragma unroll
  for(int d0=0;d0<2;++d0){s16x4 lo[4],hi[4];
    #pragma unroll
    for(int ks=0;ks<4;++ks){
      asm volatile("ds_read_b64_tr_b16 %0,%1 offset:%c2":"=&v"(lo[ks]):"v"(vb),"i"(d0*4096+ks*1024):"memory");
      asm volatile("ds_read_b64_tr_b16 %0,%1 offset:%c2":"=&v"(hi[ks]):"v"(vb),"i"(d0*4096+ks*1024+512):"memory");}
    asm volatile("s_waitcnt lgkmcnt(0)":::"memory");SBAR();
    #define PK(k) (bf16x8){lo[k][0],lo[k][1],lo[k][2],lo[k][3],hi[k][0],hi[k][1],hi[k][2],hi[k][3]}
    o[d0]=__builtin_amdgcn_mfma_f32_32x32x16_bf16(pa0,PK(0),o[d0],0,0,0);
    o[d0]=__builtin_amdgcn_mfma_f32_32x32x16_bf16(pa1,PK(1),o[d0],0,0,0);
    o[d0]=__builtin_amdgcn_mfma_f32_32x32x16_bf16(pa2,PK(2),o[d0],0,0,0);
    o[d0]=__builtin_amdgcn_mfma_f32_32x32x16_bf16(pa3,PK(3),o[d0],0,0,0);
    #undef PK
  }
}

#ifndef ATTN_STORE16
#define ATTN_STORE16(p,v) (*(u32x4*)(p)=(v))
#endif
typedef __attribute__((address_space(3))) const float* lds_fptr;
template<int THRL> __device__ __forceinline__ void attn_unit(int b,int h,int qb,const bf16*Q,const bf16*__restrict__ K,const bf16*__restrict__ V,bf16*O,char*shm,lds_fptr cl,float*ssq,const int MKW){
  const int lane=mk_lane(),r32=lane&31,hi=lane>>5; const int wid=MKW;
  const long rowbase=(long)b*SEQ; const int q0=qb*QB;
  const bf16*Qw=Q+(rowbase+q0+wid*QBLK)*DMQ+h*D;
  const bf16*Kh=K+rowbase*DMQ+h*D,*Vh=V+rowbase*DMQ+h*D;
  const unsigned lds0=(unsigned)(uintptr_t)shm;
  float*wsf=(float*)(shm+LDS_WS)+wid*64;
  const bf16*ksrc=Kh+(long)lane*DMQ+wid*8;
  const bf16*vsrc=Vh+(long)(16*(wid&3)+(lane>>2))*DMQ+(wid>>2)*32+(lane&3)*8;
  const unsigned kdst=lds0+LDS_K+wid*1024, vdst=lds0+LDS_V+wid*1024;
  #define DMA_K(t,slot) glds16(ksrc+(long)(t)*KVBLK*DMQ,(unsigned)__builtin_amdgcn_readfirstlane(kdst+(slot)))
  #define DMA_V(t,slot) glds16(vsrc+(long)(t)*KVBLK*DMQ,(unsigned)__builtin_amdgcn_readfirstlane(vdst+(slot)))
  const int vb0=(int)(lds0+LDS_V)+((lane>>4)&1)*32+(lane&3)*8+(4*hi+((lane&15)>>2))*64;
  const char*Kbase=shm+LDS_K; bf16x8 kf[8];
  const lds_cptr shm3=(lds_cptr)shm; const lds_cptr kp0=shm3+LDS_K+hi*1024+r32*16; const lds_cptr vp0=shm3+LDS_V+((lane>>4)&1)*32+(lane&3)*8+(4*hi+((lane&15)>>2))*64;
  const int NT=(q0+QB)/KVBLK;
  DMA_K(0,0);DMA_V(0,0);DMA_K(1,SLOTB);
  bf16x8 qr[4];
  #pragma unroll
  for(int d0=0;d0<4;++d0)qr[d0]=*reinterpret_cast<const bf16x8*>(&Qw[(long)r32*DMQ+d0*16+hi*8]);
  const int qrel=wid*QBLK+r32;
  #define cq (cl[q0+qrel])
  float mhat=0.f,l_reg=0.f;f32x16 o[2];o[0]=f32x16{};o[1]=f32x16{};
  float dmq=cq;
  #define PREP_LD(P0,P1,t) do{ const __attribute__((address_space(3))) f32x4_t* cp_=(const __attribute__((address_space(3))) f32x4_t*)(cl+64*(t)+4*hi); \
    _Pragma("unroll") for(int g_=0;g_<4;++g_){ const f32x4_t a_=cp_[2*g_], b_=cp_[8+2*g_]; \
      _Pragma("unroll") for(int j_=0;j_<4;++j_){ P0[4*g_+j_]=a_[j_]; P1[4*g_+j_]=b_[j_]; } } }while(0)
  #define PREP_SUB(P0,P1) do{ _Pragma("unroll") for(int r_=0;r_<16;++r_){ P0[r_]=dmq-P0[r_]; P1[r_]=dmq-P1[r_]; } }while(0)
  #define CMASK(P0,P1,t) do{int jb_=(t)-(NT-4); if(jb_>=0)cmask(P0,P1,jb_,qrel,hi);}while(0)
  bool resc=false;
  #define START(P0,P1) do{ const float rm=rowmax(P0,P1); resc=false; \
    { const float dl=rm; mhat=fadd_s(mhat,dl); \
      _Pragma("unroll") for(int r=0;r<16;++r){P0[r]=fsub_s(P0[r],dl);P1[r]=fsub_s(P1[r],dl);} \
      dmq=cq-mhat; } \
    _Pragma("unroll") for(int r=0;r<16;++r)P0[r]=__builtin_amdgcn_exp2f(P0[r]); }while(0)
  #define RESC() do{ if(resc){ asm volatile("s_waitcnt lgkmcnt(0)":::"memory"); \
      _Pragma("unroll") for(int d_=0;d_<2;++d_) _Pragma("unroll") for(int r=0;r<16;++r)o[d_][r]*=wsf[crow(r,hi)]; } }while(0)
  int sl_prev=0,sl_cur=0,sl_next=SLOTB;
  #define ROT() do{sl_prev=sl_cur;sl_cur=sl_next;sl_next=(sl_next==(NSLOT-1)*SLOTB)?0:sl_next+SLOTB;}while(0)
  DMA_K(2,2*SLOTB);
  WAIT_BAR(3);
  f32x16 pA0,pA1,pB0,pB1;
  PREP_LD(pA0,pA1,0); PREP_SUB(pA0,pA1);
  qkt(pA0,pA1,Kbase,qr,pA0,pA1,r32,hi);asm volatile("s_nop 15\n\ts_nop 7":"+v"(pA0),"+v"(pA1));CMASK(pA0,pA1,0);
  START(pA0,pA1);
  _Pragma("unroll") for(int r=0;r<16;++r)pA1[r]=__builtin_amdgcn_exp2f(pA1[r]);
  PREP_LD(pB0,pB1,1); PREP_SUB(pB0,pB1);
  WAIT_BAR(0);
  DMA_K(3,0);DMA_V(1,SLOTB);
  ROT();
  kload8(kf,kp0+sl_cur);
  WAIT_BAR(2);
  s16x4 vlo[8],vhi[8]; u32x4 pw0,pw1,pw2,pw3;
  #define PKW(P,B) cvtpk_s(P[B],P[B+1])
  #define PAF(k) __builtin_bit_cast(bf16x8,pw##k)
  #define VFR(i) (bf16x8){vlo[i][0],vlo[i][1],vlo[i][2],vlo[i][3],vhi[i][0],vhi[i][1],vhi[i][2],vhi[i][3]}
  #define PIN(x) asm volatile("":"+v"(x))
  #define MX3(a,b,c) __builtin_fmaxf(__builtin_fmaxf((a),(b)),(c))
  #define GAPA(MF,A0,A1,A2,A3,W0,W1,PW) do{ MF; sacc+=A0; sacc+=A1; sacc+=A2; sacc+=A3; PIN(sacc); W0; W1; PIN(PW); SBAR(); }while(0)
  #define EX(v) __builtin_amdgcn_exp2f(v)
  #define GAPB(MF,X,B) do{ MF; X[B]=EX(X[B]); X[B+1]=EX(X[B+1]); X[B+2]=EX(X[B+2]); X[B+3]=EX(X[B+3]); PIN(X); SBAR(); }while(0)
  #define VRD(i) do{ vlo[i]=vtr(vp_+(((i)>>2)*4096+((i)&3)*1024)); vhi[i]=vtr(vp_+(((i)>>2)*4096+((i)&3)*1024+512)); }while(0)
  #define KRD(G,j) do{ if(G){ kload2(kf,kp0+sl_next,j); SBAR(); } }while(0)
  #define STEP(C0,C1,P0,P1,t,GK,GV,GL) do{ SBAR(); \
    const lds_cptr vp_=vp0+sl_prev; \
    VRD(0); SBAR(); float sacc=(P0[0]+P0[1]); \
    GAPA(C0=__builtin_amdgcn_mfma_f32_32x32x16_bf16(kf[0],qr[0],C0,0,0,0), P0[2],P0[3],P0[4],P0[5],     pw0[0]=PKW(P0,0), pw0[1]=PKW(P0,2), pw0); \
    VRD(4); SBAR(); GAPA(C1=__builtin_amdgcn_mfma_f32_32x32x16_bf16(kf[1],qr[0],C1,0,0,0), P0[6],P0[7],P0[8],P0[9],     pw0[2]=PKW(P0,4), pw0[3]=PKW(P0,6), pw0); \
    VRD(1); SBAR(); GAPA(C0=__builtin_amdgcn_mfma_f32_32x32x16_bf16(kf[2],qr[1],C0,0,0,0),   P0[10],P0[11],P0[12],P0[13], pw1[0]=PKW(P0,8), pw1[1]=PKW(P0,10), pw1); \
    VRD(5); SBAR(); GAPA(C1=__builtin_amdgcn_mfma_f32_32x32x16_bf16(kf[3],qr[1],C1,0,0,0),   P0[14],P0[15],P1[0],P1[1],   pw1[2]=PKW(P0,12),pw1[3]=PKW(P0,14), pw1); \
    VRD(2); SBAR(); GAPA(C0=__builtin_amdgcn_mfma_f32_32x32x16_bf16(kf[4],qr[2],C0,0,0,0),   P1[2],P1[3],P1[4],P1[5],     pw2[0]=PKW(P1,0), pw2[1]=PKW(P1,2), pw2); \
    VRD(6); SBAR(); GAPA(C1=__builtin_amdgcn_mfma_f32_32x32x16_bf16(kf[5],qr[2],C1,0,0,0),   P1[6],P1[7],P1[8],P1[9],     pw2[2]=PKW(P1,4), pw2[3]=PKW(P1,6), pw2); \
    VRD(3); SBAR(); GAPA(C0=__builtin_amdgcn_mfma_f32_32x32x16_bf16(kf[6],qr[3],C0,0,0,0),   P1[10],P1[11],P1[12],P1[13], pw3[0]=PKW(P1,8), pw3[1]=PKW(P1,10), pw3); \
    VRD(7); SBAR(); GAPA(C1=__builtin_amdgcn_mfma_f32_32x32x16_bf16(kf[7],qr[3],C1,0,0,0),   P1[14],P1[15],0.f,0.f,       pw3[2]=PKW(P1,12),pw3[3]=PKW(P1,14), pw3); \
    l_reg+=sacc; \
    if(GK){DMA_K((t)+3,sl_cur);} if(GV){DMA_V((t)+1,sl_next);} \
    CMASK(C0,C1,t); \
    { float a=MX3(C0[0],C0[1],C1[0]),b=MX3(C0[2],C0[3],C1[1]); a=MX3(a,C1[2],C1[3]); \
      _Pragma("unroll") for(int r=4;r<16;r+=4){a=MX3(a,C0[r],C0[r+1]);b=MX3(b,C0[r+2],C0[r+3]);a=MX3(a,C1[r],C1[r+1]);b=MX3(b,C1[r+2],C1[r+3]);} \
      float rm=__builtin_fmaxf(a,b); { auto rr=__builtin_amdgcn_permlane32_swap(__float_as_uint(rm),__float_as_uint(rm),false,false); rm=__builtin_fmaxf(__uint_as_float(rr[0]),__uint_as_float(rr[1])); } \
      resc=false; \
      if(__builtin_expect(__any(rm>(float)THRL),0)){ const float dl=__builtin_fmaxf(rm,0.f); mhat+=dl; \
        _Pragma("unroll") for(int r=0;r<16;++r){C0[r]-=dl;C1[r]-=dl;} \
        dmq=cq-mhat; \
        const float f=__builtin_amdgcn_exp2f(-dl); l_reg*=f; if(hi==0)wsf[r32]=f; resc=true; } } \
    if(GL){ PREP_LD(P0,P1,(t)+1); } SBAR(); \
    GAPB(o[0]=__builtin_amdgcn_mfma_f32_32x32x16_bf16(PAF(0),VFR(0),o[0],0,0,0), C0,0); \
    GAPB(o[1]=__builtin_amdgcn_mfma_f32_32x32x16_bf16(PAF(0),VFR(4),o[1],0,0,0), C0,4); \
    KRD(GL,0); GAPB(o[0]=__builtin_amdgcn_mfma_f32_32x32x16_bf16(PAF(1),VFR(1),o[0],0,0,0), C0,8); \
    KRD(GL,1); GAPB(o[1]=__builtin_amdgcn_mfma_f32_32x32x16_bf16(PAF(1),VFR(5),o[1],0,0,0), C0,12); \
    KRD(GL,2); GAPB(o[0]=__builtin_amdgcn_mfma_f32_32x32x16_bf16(PAF(2),VFR(2),o[0],0,0,0), C1,0); \
    KRD(GL,3); GAPB(o[1]=__builtin_amdgcn_mfma_f32_32x32x16_bf16(PAF(2),VFR(6),o[1],0,0,0), C1,4); \
    GAPB(o[0]=__builtin_amdgcn_mfma_f32_32x32x16_bf16(PAF(3),VFR(3),o[0],0,0,0), C1,8); \
    GAPB(o[1]=__builtin_amdgcn_mfma_f32_32x32x16_bf16(PAF(3),VFR(7),o[1],0,0,0), C1,12); \
    if(GL){ PREP_SUB(P0,P1); } \
    }while(0)
  int t=1;
  #undef CMASK
  #define CMASK(P0,P1,t) do{}while(0)
  for(;t+5<NT;t+=2){
    STEP(pB0,pB1,pA0,pA1,t,true,true,true);     WAIT_BAR(2); RESC(); ROT();
    STEP(pA0,pA1,pB0,pB1,t+1,true,true,true);   WAIT_BAR(2); RESC(); ROT();
  }
  #undef CMASK
  #define CMASK(P0,P1,t) do{int jb_=(t)-(NT-4); if(jb_>=0)cmask(P0,P1,jb_,qrel,hi);}while(0)
  #define ENDW(tt) do{ if((tt)+3<NT){WAIT_BAR(2);} else if((tt)+2<NT){WAIT_BAR(1);} else {WAIT_BAR(0);} }while(0)
  for(;t+1<NT;t+=2){
    STEP(pB0,pB1,pA0,pA1,t,(t+3<NT),(t+1<NT),(t+1<NT));       ENDW(t);   RESC(); ROT();
    STEP(pA0,pA1,pB0,pB1,t+1,(t+4<NT),(t+2<NT),(t+2<NT));     ENDW(t+1); RESC(); ROT();
  }
  STEP(pB0,pB1,pA0,pA1,NT-1,false,false,false); RESC();
  { float sacc=pB0[0]+pB0[1]; _Pragma("unroll") for(int r=2;r<16;++r)sacc+=pB0[r]; _Pragma("unroll") for(int r=0;r<16;++r)sacc+=pB1[r]; l_reg+=sacc;
    pw0=(u32x4){PKW(pB0,0),PKW(pB0,2),PKW(pB0,4),PKW(pB0,6)};pw1=(u32x4){PKW(pB0,8),PKW(pB0,10),PKW(pB0,12),PKW(pB0,14)};pw2=(u32x4){PKW(pB1,0),PKW(pB1,2),PKW(pB1,4),PKW(pB1,6)};pw3=(u32x4){PKW(pB1,8),PKW(pB1,10),PKW(pB1,12),PKW(pB1,14)};
    SBAR(); pv(o,vb0+sl_cur,PAF(0),PAF(1),PAF(2),PAF(3)); }
  #undef PKW
  #undef PAF
  #undef VFR
  #undef PIN
  #undef MX3
  #undef GAPA
  #undef GAPB
  #undef EX
  #undef VRD
  #undef KRD
  #undef STEP
  #undef ENDW
  {auto rr=__builtin_amdgcn_permlane32_swap(__float_as_uint(l_reg),__float_as_uint(l_reg),false,false);l_reg=__uint_as_float(rr[0])+__uint_as_float(rr[1]);}
  if(hi==0)wsf[32+r32]=l_reg;asm volatile("s_waitcnt lgkmcnt(0)":::"memory");
  float rli[16];
  #pragma unroll
  for(int r=0;r<16;++r)rli[r]=__builtin_amdgcn_rcpf(wsf[32+crow(r,hi)]);
  bf16*Ow=O+(rowbase+q0+wid*QBLK)*DMO+h*D; float*sq=ssq+rowbase+q0+wid*QBLK;
  { bf16*stg=(bf16*)(shm+LDS_OST)+wid*2048;
    #pragma unroll
    for(int r=0;r<16;++r){const int orow=crow(r,hi);
      #pragma unroll
      for(int d0=0;d0<2;++d0)stg[orow*64+d0*32+r32]=__float2bfloat16(o[d0][r]*rli[r]);}
    asm volatile("s_waitcnt lgkmcnt(0)":::"memory");
    #pragma unroll
    for(int i=0;i<4;++i){const int row=i*8+(lane>>3),ch=lane&7; const u32x4 v=*(const u32x4*)(stg+row*64+ch*8); ATTN_STORE16(Ow+(long)row*DMO+ch*8,v);
      float q2=0.f; _Pragma("unroll") for(int e=0;e<4;++e){ const float lo_=__uint_as_float(v[e]<<16), hi_=__uint_as_float(v[e]&0xffff0000u); q2+=lo_*lo_+hi_*hi_; }
      q2+=__shfl_xor(q2,1); q2+=__shfl_xor(q2,2); q2+=__shfl_xor(q2,4); if(ch==0)unsafeAtomicAdd(sq+row,q2);} }
  asm volatile("s_waitcnt lgkmcnt(0)\n\ts_barrier":::"memory");
  #undef DMA_K
  #undef DMA_V
  #undef cq
  #undef CMASK
  #undef PREP_LD
  #undef PREP_SUB
  #undef START
  #undef RESC
  #undef ROT
}
constexpr int ATTN_LDS_BYTES=LDS_BYTES;
__device__ __forceinline__ void swa_unit(int b,int kvh,int qblk,const bf16*Q,const bf16*__restrict__ K,const bf16*__restrict__ V,bf16*O,const float*sinks,float*ssq,char*shm,const int MKW){
  const int lane=mk_lane(),r32=lane&31,hi=lane>>5; const int wid=MKW;
  const long rowbase=(long)b*SEQ; const int q0=qblk*64, jh=wid&1, hq=kvh*4+(wid>>1);
  const bf16*Qw=Q+(rowbase+q0+32*jh)*DMQ+hq*D;
  const bf16*Kh=K+rowbase*DMQ+kvh*D,*Vh=V+rowbase*DMQ+kvh*D;
  const unsigned lds0=(unsigned)(uintptr_t)shm;
  float*wsf=(float*)(shm+LDS_WS)+wid*64;
  const bf16*ksrc=Kh+(long)lane*DMQ+wid*8;
  const bf16*vsrc=Vh+(long)(16*(wid&3)+(lane>>2))*DMQ+(wid>>2)*32+(lane&3)*8;
  const unsigned kdst=lds0+LDS_K+wid*1024, vdst=lds0+LDS_V+wid*1024;
  const int vb0=(int)(lds0+LDS_V)+((lane>>4)&1)*32+(lane&3)*8+(4*hi+((lane&15)>>2))*64;
  const char*Kbase=shm+LDS_K;
  const int nt=qblk>=2?3:qblk+1;
  #pragma unroll
  for(int i=0;i<3;++i){ if(i<nt){ const int tile=(i==0)?(qblk>=1?qblk-1:qblk):(i==1?qblk:qblk-2);
      glds16(ksrc+(long)tile*KVBLK*DMQ,(unsigned)__builtin_amdgcn_readfirstlane(kdst+i*SLOTB)); glds16(vsrc+(long)tile*KVBLK*DMQ,(unsigned)__builtin_amdgcn_readfirstlane(vdst+i*SLOTB)); } }
  bf16x8 qr[4];
  #pragma unroll
  for(int d0=0;d0<4;++d0)qr[d0]=*reinterpret_cast<const bf16x8*>(&Qw[(long)r32*DMQ+d0*16+hi*8]);
  float mhat=0.f,l_reg=0.f;f32x16 o[2];o[0]=f32x16{};o[1]=f32x16{};f32x16 negm=f32x16{};
  const int tq=q0+32*jh+r32;
  WAIT_BAR(0);
  #pragma unroll
  for(int i=0;i<3;++i){ if(i<nt){ const int tile=(i==0)?(qblk>=1?qblk-1:qblk):(i==1?qblk:qblk-2);
    f32x16 p0,p1;
    qkt(p0,p1,Kbase+i*SLOTB,qr,negm,negm,r32,hi); asm volatile("s_nop 15\n\ts_nop 7":"+v"(p0),"+v"(p1));
    { const int kb=tile*64+4*hi;
      #pragma unroll
      for(int r=0;r<16;++r){ const int dd=tq-(kb+(r&3)+8*(r>>2)); if(dd<0||dd>=128)p0[r]=-INFINITY; if(dd-32<0||dd-32>=128)p1[r]=-INFINITY; } }
    const float rm=rowmax(p0,p1);
    if(i==0){ mhat=rm;
      #pragma unroll
      for(int r=0;r<16;++r){p0[r]-=rm;p1[r]-=rm;} }
    else { const float dl=fmaxf(rm,0.f);
      if(__any(dl>0.f)){ mhat+=dl;
        #pragma unroll
        for(int r=0;r<16;++r){p0[r]-=dl;p1[r]-=dl;}
        const float f=__builtin_amdgcn_exp2f(-dl); l_reg*=f; if(hi==0)wsf[r32]=f; asm volatile("s_waitcnt lgkmcnt(0)":::"memory");
        #pragma unroll
        for(int d_=0;d_<2;++d_){
          #pragma unroll
          for(int r=0;r<16;++r)o[d_][r]*=wsf[crow(r,hi)]; }
        asm volatile("s_waitcnt lgkmcnt(0)":::"memory"); } }
    #pragma unroll
    for(int r=0;r<16;++r)negm[r]=-mhat;
    float sacc=0.f;
    #pragma unroll
    for(int r=0;r<16;++r){p0[r]=__builtin_amdgcn_exp2f(p0[r]);p1[r]=__builtin_amdgcn_exp2f(p1[r]);sacc+=p0[r]+p1[r];}
    l_reg+=sacc;
    u32x4 pw0,pw1,pw2,pw3;
    pw0=(u32x4){cvtpk_s(p0[0],p0[1]),cvtpk_s(p0[2],p0[3]),cvtpk_s(p0[4],p0[5]),cvtpk_s(p0[6],p0[7])};
    pw1=(u32x4){cvtpk_s(p0[8],p0[9]),cvtpk_s(p0[10],p0[11]),cvtpk_s(p0[12],p0[13]),cvtpk_s(p0[14],p0[15])};
    pw2=(u32x4){cvtpk_s(p1[0],p1[1]),cvtpk_s(p1[2],p1[3]),cvtpk_s(p1[4],p1[5]),cvtpk_s(p1[6],p1[7])};
    pw3=(u32x4){cvtpk_s(p1[8],p1[9]),cvtpk_s(p1[10],p1[11]),cvtpk_s(p1[12],p1[13]),cvtpk_s(p1[14],p1[15])};
    SBAR(); pv(o,vb0+i*SLOTB,__builtin_bit_cast(bf16x8,pw0),__builtin_bit_cast(bf16x8,pw1),__builtin_bit_cast(bf16x8,pw2),__builtin_bit_cast(bf16x8,pw3)); } }
  {auto rr=__builtin_amdgcn_permlane32_swap(__float_as_uint(l_reg),__float_as_uint(l_reg),false,false);l_reg=__uint_as_float(rr[0])+__uint_as_float(rr[1]);}
  l_reg+=__builtin_amdgcn_exp2f(sinks[hq]*1.4426950408889634f-mhat);
  if(hi==0)wsf[32+r32]=l_reg;asm volatile("s_waitcnt lgkmcnt(0)":::"memory");
  float rli[16];
  #pragma unroll
  for(int r=0;r<16;++r)rli[r]=__builtin_amdgcn_rcpf(wsf[32+crow(r,hi)]);
  bf16*Ow=O+(rowbase+q0+32*jh)*DMO+hq*D; float*sq=ssq+rowbase+q0+32*jh;
  { bf16*stg=(bf16*)(shm+LDS_OST)+wid*2048;
    #pragma unroll
    for(int r=0;r<16;++r){const int orow=crow(r,hi);
      #pragma unroll
      for(int d0=0;d0<2;++d0)stg[orow*64+d0*32+r32]=__float2bfloat16(o[d0][r]*rli[r]);}
    asm volatile("s_waitcnt lgkmcnt(0)":::"memory");
    #pragma unroll
    for(int i=0;i<4;++i){const int row=i*8+(lane>>3),ch=lane&7; const u32x4 v=*(const u32x4*)(stg+row*64+ch*8); ATTN_STORE16(Ow+(long)row*DMO+ch*8,v);
      float q2=0.f; _Pragma("unroll") for(int e=0;e<4;++e){ const float lo_=__uint_as_float(v[e]<<16), hi_=__uint_as_float(v[e]&0xffff0000u); q2+=lo_*lo_+hi_*hi_; }
      q2+=__shfl_xor(q2,1); q2+=__shfl_xor(q2,2); q2+=__shfl_xor(q2,4); if(ch==0)unsafeAtomicAdd(sq+row,q2);} }
  asm volatile("s_waitcnt lgkmcnt(0)\n\ts_barrier":::"memory");
}
struct AttnArgs { const bf16* proj; bf16* att; const float* c; const float* sinks; float* ssqA; float* ssqB; };
template<int THRL=8> __device__ __forceinline__ void attn_phase(char*lds,const AttnArgs&A,int vcu,int G,const int MKW){
  const int tid=MKW*64+mk_lane();
  for(int u=vcu;u<BATCH*2*(SEQ/64);u+=G){ const int qblk=u%(SEQ/64), bk=u/(SEQ/64); swa_unit(bk>>1,bk&1,qblk,A.proj+0,A.proj+512,A.proj+640,A.att,A.sinks,A.ssqA,lds,MKW); }
  if(vcu<BATCH*NHEAD*16){ const int bh=vcu>>4, s=vcu&15;
    __attribute__((address_space(3))) float* cl=(__attribute__((address_space(3))) float*)((__attribute__((address_space(3))) char*)(uintptr_t)(unsigned)(uintptr_t)lds+86016);
    { const float* cg=A.c+(long)bh*SEQ;
      for(int i=tid;i<SEQ/4;i+=NW*64){ f32x4_t v=((const f32x4_t*)cg)[i]; v=v*1.4426950408889634f; ((__attribute__((address_space(3))) f32x4_t*)cl)[i]=v; } }
    asm volatile("s_waitcnt vmcnt(0) lgkmcnt(0)\n\ts_barrier":::"memory");
    #pragma unroll 1
    for(int i=0;i<2;++i){ const int qb=(i==0)?s:31-s; attn_unit<THRL>(bh>>3,bh&7,qb,A.proj+768,A.proj+1280,A.proj+1792,A.att+512,lds,(lds_fptr)cl,A.ssqB,MKW); } }
}
#undef SBAR
#undef WAIT_BAR
}
constexpr int BATCH = 2, SEQ = 8192, D = 1024, M = BATCH * SEQ;
constexpr int INW = 2312, NPROJ = 2304;
constexpr int PC_QA = 0, PC_KA = 512, PC_VA = 640, PC_QF = 768, PC_KF = 1280, PC_VF = 1792;
constexpr int NEXP = 16384, PLE_DIM = 256, NSC = 2048;
constexpr float RMS_EPS = 1e-6f;
constexpr size_t MiB = 1u << 20, KiB = 1024;
constexpr size_t WS_CTL = 0, CTL_ZERO_BYTES = 512 * KiB;
constexpr size_t WS_SSQ = 64 * KiB;
constexpr size_t WS_C = 512 * KiB;
constexpr size_t WS_WIN = 1 * MiB, WS_WOUT = WS_WIN + 4608 * KiB, WS_WEFF = WS_WOUT + 2 * MiB, WS_WPG = WS_WEFF + 4 * MiB, WS_WPP = WS_WPG + 2 * MiB;
constexpr size_t WS_ROPE = 14 * MiB;
constexpr size_t WS_PB = 16 * MiB;
constexpr size_t WS_U = 24 * MiB, WS_V = 56 * MiB;
constexpr size_t WS_XN = 88 * MiB;
constexpr size_t WS_PROJ = 120 * MiB;
constexpr size_t WS_H2B = 120 * MiB, WS_IDX = 152 * MiB, WS_GATE = 156 * MiB;
constexpr size_t WS_ATT = 192 * MiB;
constexpr size_t WS_PLE = 224 * MiB;
constexpr size_t WS_END = 256 * MiB;
static_assert(WS_WPP + 512 * KiB <= WS_ROPE && WS_PROJ + (size_t)M * NPROJ * 2 <= WS_ATT && WS_PLE + (size_t)M * D * 2 <= WS_END, "d_ws map");
constexpr int CW_TMO = 0, CW_CODE = 1, CW_BAR = 4096;
constexpr int RING_OFF = 0, RING_BYTES = 131072;
constexpr int LDSCTL_OFF = 135168, MISC_OFF = LDSCTL_OFF + 320, TAB_OFF = LDSCTL_OFF + 512, PTAB_OFF = LDSCTL_OFF + 2560;
constexpr int LDS_BYTES = 147456;
constexpr int NWAVES = 8;
#define GAS __attribute__((address_space(1)))
#define LAS __attribute__((address_space(3)))
typedef unsigned short bf16;
typedef unsigned v4u __attribute__((ext_vector_type(4)));
typedef float f32x4 __attribute__((ext_vector_type(4)));
typedef short bf16x8 __attribute__((ext_vector_type(8)));
typedef GAS unsigned gu32;
typedef GAS unsigned long long gu64;
#define RLX_AGENT __ATOMIC_RELAXED, __HIP_MEMORY_SCOPE_AGENT
#define LDS_WAIT() asm volatile("s_waitcnt lgkmcnt(0)" ::: "memory")
#define VM_WAIT() asm volatile("s_waitcnt vmcnt(0)" ::: "memory")
__device__ __forceinline__ unsigned long long rt() { return __builtin_amdgcn_s_memrealtime(); }
__device__ __forceinline__ unsigned f2bf(float f) { unsigned u = __builtin_bit_cast(unsigned, f); return (u + 0x7fffu + ((u >> 16) & 1u)) >> 16; }
__device__ __forceinline__ unsigned pk2(float lo, float hi) { return f2bf(lo) | (f2bf(hi) << 16); }

#define XB_TMO      128
#define XB_XCNT(j)  (256  + 64 * (j))
#define XB_XSUB(j)  (1280 + 64 * (j))
#define XB_XGEN(j)  (2304 + 64 * (j))
#define XB_TOP      3328
#define XB_TOPGEN   3392
#define XCD_BAR_WORDS 3456
#define XB_SPIN_CAP (1u << 18)

__device__ __forceinline__ unsigned xb_ld(unsigned* p)              { return __hip_atomic_load(p, __ATOMIC_RELAXED, __HIP_MEMORY_SCOPE_AGENT); }
__device__ __forceinline__ unsigned xb_add(unsigned* p, unsigned v) { return __hip_atomic_fetch_add(p, v, __ATOMIC_RELAXED, __HIP_MEMORY_SCOPE_AGENT); }
__device__ __forceinline__ unsigned xb_xcc_id() { return (unsigned)__builtin_amdgcn_s_getreg((3 << 11) | 20) & 0xFu; }
#define XB_SPIN(cond, bar) do { unsigned _sp = 0; while (cond) { __builtin_amdgcn_s_sleep(1); \
    if ((++_sp & 255u) == 0u) { if (xb_ld(&(bar)[XB_TMO])) break; if (_sp > XB_SPIN_CAP) { atomicAdd(&(bar)[XB_TMO], 1u); break; } } } } while (0)

struct XcdBarrier {
    unsigned* bar; unsigned x;
    volatile LAS unsigned* st;
};

__device__ __forceinline__ XcdBarrier xcd_barrier_post(unsigned* bar, volatile LAS unsigned* st, const int MKW) {
    XcdBarrier b; b.bar = bar; b.x = xb_xcc_id(); b.st = st;
    if (MKW == 0 && mk_lane() == 0) (void)xb_add(&bar[XB_XCNT(b.x)], 1u);
    return b;
}
__device__ __forceinline__ void xcd_barrier_complete(unsigned* bar, unsigned x, unsigned& nloc, unsigned& nx) {
    const unsigned G = gridDim.x * gridDim.y * gridDim.z;
    unsigned sum, cnt, mine, sp = 0u;
    for (;;) {
        sum = 0u; cnt = 0u; mine = 0u;
#pragma unroll
        for (unsigned j = 0; j < 16; ++j) { const unsigned c = xb_ld(&bar[XB_XCNT(j)]); sum += c; cnt += (c > 0u) ? 1u : 0u; mine = (j == x) ? c : mine; }
        if (sum == G) break;
        __builtin_amdgcn_s_sleep(1);
        if ((++sp & 255u) == 0u) { if (xb_ld(&bar[XB_TMO])) break; if (sp > XB_SPIN_CAP) { atomicAdd(&bar[XB_TMO], 1u); break; } }
    }
    nloc = mine > 0u ? mine : 1u; nx = cnt > 0u ? cnt : 1u;
}

__device__ __forceinline__ void xcd_barrier(const XcdBarrier& b, const int MKW) {
    asm volatile("s_waitcnt vmcnt(0)" ::: "memory");
    __syncthreads();
    if (MKW == 0 && mk_lane() == 0) {
        unsigned* bar = b.bar;
        __builtin_amdgcn_s_waitcnt(0);
        unsigned nloc = b.st[0], nx = b.st[1];
        if (nloc == 0u) { xcd_barrier_complete(bar, b.x, nloc, nx); b.st[0] = nloc; b.st[1] = nx; }
        const unsigned old = xb_add(&bar[XB_XSUB(b.x)], 1u);
        const unsigned gen = old / nloc;
        if (old + 1u == (gen + 1u) * nloc) {
            __builtin_amdgcn_fence(__ATOMIC_RELEASE, "agent");
            asm volatile("s_waitcnt vmcnt(0)" ::: "memory");
            const unsigned og = xb_add(&bar[XB_TOP], 1u);
            const unsigned tg = og / nx;
            if (og + 1u == (tg + 1u) * nx) xb_add(&bar[XB_TOPGEN], 1u);
            else XB_SPIN(xb_ld(&bar[XB_TOPGEN]) == tg, bar);
            __builtin_amdgcn_fence(__ATOMIC_ACQUIRE, "agent");
            xb_add(&bar[XB_XGEN(b.x)], 1u);
            asm volatile("s_waitcnt vmcnt(0)" ::: "memory");
        } else {
            XB_SPIN(xb_ld(&bar[XB_XGEN(b.x)]) == gen, bar);
            __builtin_amdgcn_fence(__ATOMIC_ACQUIRE, "agent");
            asm volatile("s_waitcnt vmcnt(0)" ::: "memory");
        }
    }
    __syncthreads();
}
typedef float f32x2g __attribute__((ext_vector_type(2)));
struct Frame {
    LAS unsigned char* lds;
    volatile LAS unsigned* MISC;
    gu32* ctl;
    int wave;
    int vcu, G;
    float* out; unsigned char* ws;
};
enum { I_X = 0, I_P, I_GMIX, I_WIN, I_BF, I_SINKS, I_GA, I_GB, I_WOUT, I_GFFN, I_WQ, I_SK, I_EU, I_EV, I_GPLE, I_WPG, I_WPP, I_GFIN };
__device__ __forceinline__ const float* inptr(const Frame& F, int i) {
    const unsigned long long v = ((volatile LAS unsigned long long*)(F.lds + PTAB_OFF))[i];
    const unsigned lo = (unsigned)__builtin_amdgcn_readfirstlane((int)(unsigned)v), hi = (unsigned)__builtin_amdgcn_readfirstlane((int)(unsigned)(v >> 32));
    return (const float*)(((unsigned long long)hi << 32) | lo);
}
#define mk_tid() (F.wave * 64 + mk_lane())
__device__ __forceinline__ float wave_sum(float v) {
#pragma unroll
    for (int o = 1; o < 64; o <<= 1) v += __shfl_xor(v, o);
    return v;
}
__device__ __forceinline__ void p0_transpose_item(const float* W, int ldw, int K, int nblk, const float* gain, int rope_lim, bf16* WT, LAS float* scr, int item, int lane) {
    const int kb = item / nblk, nb = item % nblk, k0 = 64 * kb, n0 = 32 * nb;
#pragma unroll 8
    for (int i = 0; i < 32; ++i) { const int kk = 2 * i + (lane >> 5); float v = W[(size_t)(k0 + kk) * ldw + n0 + (lane & 31)]; if (gain) v *= gain[k0 + kk]; scr[kk * 33 + (lane & 31)] = v; }
    LDS_WAIT(); asm volatile("" ::: "memory");
    const int c = lane & 7;
#pragma unroll
    for (int j = 0; j < 4; ++j) { const int n = (lane >> 3) + 8 * j; const LAS float* s = scr + (8 * c) * 33 + n;
        v4u o; o.x = pk2(s[0 * 33], s[1 * 33]); o.y = pk2(s[2 * 33], s[3 * 33]); o.z = pk2(s[4 * 33], s[5 * 33]); o.w = pk2(s[6 * 33], s[7 * 33]);
        int nn = n0 + n; if (nn < rope_lim) { const int pp = nn & 63; nn = (nn & ~63) + (pp < 32 ? 2 * pp : 2 * (pp - 32) + 1); }
        *(GAS v4u*)(WT + (size_t)nn * K + k0 + 8 * c) = o; }
    LDS_WAIT(); asm volatile("" ::: "memory");
}
__device__ __forceinline__ void p0_weff_item(const float* wq, const float* sk, const float* gain, bf16* WT, LAS float* scr, int item, int lane) {
    const int kb = item >> 6, nb = item & 63, k0 = 32 * kb, n0 = 32 * nb, hc = n0 >> 7, c = hc & 1, key = (n0 & 127) + (lane & 31);
    const f32x4* skr = (const f32x4*)(sk + ((size_t)c * 128 + key) * 128);
    float acc[16];
#pragma unroll
    for (int i = 0; i < 16; ++i) acc[i] = 0.f;
    for (int d4 = 0; d4 < 32; ++d4) { const f32x4 s = skr[d4];
#pragma unroll
        for (int i = 0; i < 16; ++i) { const int kk = 2 * i + (lane >> 5); const f32x4 w = *(const f32x4*)(wq + (size_t)(k0 + kk) * 2048 + hc * 128 + d4 * 4);
            acc[i] += (w[0] * s[0] + w[1] * s[1]) + (w[2] * s[2] + w[3] * s[3]); } }
#pragma unroll
    for (int i = 0; i < 16; ++i) { const int kk = 2 * i + (lane >> 5); scr[kk * 33 + (lane & 31)] = acc[i] * gain[k0 + kk]; }
    LDS_WAIT(); asm volatile("" ::: "memory");
#pragma unroll
    for (int j = 0; j < 2; ++j) { const int piece = lane + 64 * j, n = piece >> 2, ch = piece & 3; const LAS float* s = scr + (8 * ch) * 33 + n;
        v4u o; o.x = pk2(s[0 * 33], s[1 * 33]); o.y = pk2(s[2 * 33], s[3 * 33]); o.z = pk2(s[4 * 33], s[5 * 33]); o.w = pk2(s[6 * 33], s[7 * 33]);
        *(GAS v4u*)(WT + (size_t)(n0 + n) * 1024 + k0 + 8 * ch) = o; }
    LDS_WAIT(); asm volatile("" ::: "memory");
}
__device__ __forceinline__ void p0_xn_row(Frame& F, int lane, int m, const LAS float* GL, const float* x, const float* g_mix, const float* b_forget) {
    const GAS f32x4* xr = (const GAS f32x4*)(x + (size_t)m * D) + lane; const f32x4* gr = (const f32x4*)g_mix + lane;
    f32x4 v[4]; float s = 0.f;
#pragma unroll
    for (int j = 0; j < 4; ++j) { v[j] = xr[64 * j]; s += (v[j].x * v[j].x + v[j].y * v[j].y) + (v[j].z * v[j].z + v[j].w * v[j].w); }
    const float rstd = 1.0f / sqrtf(wave_sum(s) * (1.f / D) + RMS_EPS);
#pragma unroll
    for (int j = 0; j < 4; ++j) v[j] = v[j] * rstd * gr[64 * j];
    bf16* orow = (bf16*)(F.ws + WS_XN) + (size_t)m * D;
    GAS unsigned long long* o8 = (GAS unsigned long long*)orow + lane;
#pragma unroll
    for (int j = 0; j < 4; ++j) o8[64 * j] = (unsigned long long)pk2(v[j].x, v[j].y) | ((unsigned long long)pk2(v[j].z, v[j].w) << 32);
    float z[8];
#pragma unroll
    for (int h = 0; h < 8; ++h) { float a = 0.f;
#pragma unroll
        for (int j = 0; j < 4; ++j) { const f32x4 g = *(const LAS f32x4*)(GL + h * 1024 + 4 * lane + 256 * j); a += (v[j].x * g[0] + v[j].y * g[1]) + (v[j].z * g[2] + v[j].w * g[3]); }
        z[h] = wave_sum(a); }
    if (lane < 8) { float zz = z[0];
#pragma unroll
        for (int h = 1; h < 8; ++h) zz = (lane == h) ? z[h] : zz;
        zz += b_forget[lane];
        const float lf = fminf(zz, 0.f) - log1pf(expf(-fabsf(zz)));
        const int b = m / SEQ, sidx = m % SEQ;
        ((float*)(F.ws + WS_C))[((size_t)b * 8 + lane) * SEQ + sidx] = lf; }
}
__device__ __forceinline__ void p0_prologue(Frame& F) {
    const int tid = mk_tid(), lane = tid & 63;
    const float *x = inptr(F, I_X), *pp = inptr(F, I_P), *g_mix = inptr(F, I_GMIX), *w_in = inptr(F, I_WIN), *b_forget = inptr(F, I_BF), *g_out_a = inptr(F, I_GA), *g_out_b = inptr(F, I_GB), *w_out = inptr(F, I_WOUT),
                *g_ffn = inptr(F, I_GFFN), *w_query = inptr(F, I_WQ), *sub_keys = inptr(F, I_SK), *expert_u = inptr(F, I_EU), *expert_v = inptr(F, I_EV), *g_ple = inptr(F, I_GPLE), *w_ple_gate = inptr(F, I_WPG), *w_ple_proj = inptr(F, I_WPP);
    LAS float* GL = (LAS float*)(F.lds + RING_OFF + 73728);
    for (int col = tid; col < D; col += NWAVES * 64) { const f32x4 a = *(const f32x4*)(w_in + (size_t)col * INW + NPROJ), b = *(const f32x4*)(w_in + (size_t)col * INW + NPROJ + 4);
        GL[0 * 1024 + col] = a[0]; GL[1 * 1024 + col] = a[1]; GL[2 * 1024 + col] = a[2]; GL[3 * 1024 + col] = a[3]; GL[4 * 1024 + col] = b[0]; GL[5 * 1024 + col] = b[1]; GL[6 * 1024 + col] = b[2]; GL[7 * 1024 + col] = b[3]; }
    __syncthreads();
    LAS float* scr = (LAS float*)(F.lds + RING_OFF + F.wave * 9216);
    const int gw = F.vcu * NWAVES + F.wave, NGW = F.G * NWAVES;
    for (int it = gw; it < 2048; it += NGW) p0_weff_item(w_query, sub_keys, g_ffn, (bf16*)(F.ws + WS_WEFF), scr, it, lane);
    constexpr int I_IN = 16 * 72, I_OUT = 16 * 32, I_PG = 16 * 32, I_PP = 4 * 32;
    for (int it = gw; it < I_IN + I_OUT + I_PG + I_PP; it += NGW) { int r = it;
        if (r < I_IN) { p0_transpose_item(w_in, INW, D, 72, nullptr, 640, (bf16*)(F.ws + WS_WIN), scr, r, lane); continue; } r -= I_IN;
        if (r < I_OUT) { const int kb = r / 32; p0_transpose_item(w_out, D, D, 32, kb < 8 ? g_out_a : g_out_b - 512, 0, (bf16*)(F.ws + WS_WOUT), scr, r, lane); continue; } r -= I_OUT;
        if (r < I_PG) { p0_transpose_item(w_ple_gate, D, D, 32, g_ple, 0, (bf16*)(F.ws + WS_WPG), scr, r, lane); continue; } r -= I_PG;
        p0_transpose_item(w_ple_proj, D, PLE_DIM, 32, nullptr, 0, (bf16*)(F.ws + WS_WPP), scr, r, lane); }
    for (int e = gw * 64 + lane; e < SEQ * 32; e += NGW * 64) { const int pos = e >> 5, i = e & 31; double inv = 1.0;
        for (int q = 0; q < i; ++q) inv *= 0.7498942093324559;
        const double rev = (double)pos * inv * 0.15915494309189535; const float fr = (float)(rev - __builtin_rint(rev));
        ((f32x2g*)(F.ws + WS_ROPE))[e] = (f32x2g){__builtin_amdgcn_cosf(fr), __builtin_amdgcn_sinf(fr)}; }
    for (int m = gw; m < M; m += NGW) p0_xn_row(F, lane, m, GL, x, g_mix, b_forget);
    for (int m = gw; m < M; m += NGW) { const f32x4 v = *((const GAS f32x4*)(pp + (size_t)m * PLE_DIM) + lane);
        *((GAS unsigned long long*)((bf16*)(F.ws + WS_PB) + (size_t)m * PLE_DIM) + lane) = (unsigned long long)pk2(v.x, v.y) | ((unsigned long long)pk2(v.z, v.w) << 32); }
    for (int r = gw; r < 2 * NEXP; r += NGW) { const int tb = r >> 14, e = r & (NEXP - 1); const GAS f32x4* src = (const GAS f32x4*)((tb ? expert_v : expert_u) + (size_t)e * D) + lane;
        GAS unsigned long long* dst = (GAS unsigned long long*)((bf16*)(F.ws + (tb ? WS_V : WS_U)) + (size_t)e * D) + lane; const f32x4* gr = (const f32x4*)g_ffn + lane;
#pragma unroll
        for (int j = 0; j < 4; ++j) { f32x4 v = src[64 * j]; if (!tb) v = v * gr[64 * j]; dst[64 * j] = (unsigned long long)pk2(v.x, v.y) | ((unsigned long long)pk2(v.z, v.w) << 32); } }
}
__device__ __forceinline__ void p1_cumsum(Frame& F, int bh) {
    const int tid = mk_tid(), lane = tid & 63;
    float* c = (float*)(F.ws + WS_C) + (size_t)bh * SEQ + tid * 16; LAS float* sc = (LAS float*)(F.lds + RING_OFF);
    f32x4 v[4];
#pragma unroll
    for (int j = 0; j < 4; ++j) v[j] = ((const f32x4*)c)[j];
    float run = 0.f;
#pragma unroll
    for (int j = 0; j < 4; ++j) { v[j].x += run; v[j].y += v[j].x; v[j].z += v[j].y; v[j].w += v[j].z; run = v[j].w; }
    float inc = run;
#pragma unroll
    for (int o = 1; o < 64; o <<= 1) { const float t = __shfl_up(inc, o); if (lane >= o) inc += t; }
    if (lane == 63) sc[F.wave] = inc;
    __syncthreads();
    float base = inc - run;
    for (int w = 0; w < F.wave; ++w) base += sc[w];
#pragma unroll
    for (int j = 0; j < 4; ++j) { v[j] = v[j] + base; ((f32x4*)c)[j] = v[j]; }
    __syncthreads();
}
typedef __bf16 bf16x2_t __attribute__((ext_vector_type(2)));
__device__ __forceinline__ float dot2bf(unsigned a, unsigned b, float c) { return __builtin_amdgcn_fdot2_f32_bf16(__builtin_bit_cast(bf16x2_t, a), __builtin_bit_cast(bf16x2_t, b), c, false); }
__device__ __forceinline__ float dot8bf(const v4u& a, const v4u& b, float c) { c = dot2bf(a.x, b.x, c); c = dot2bf(a.y, b.y, c); c = dot2bf(a.z, b.z, c); return dot2bf(a.w, b.w, c); }
__device__ __forceinline__ float swap32_add(float a, float b) {
    auto rr = __builtin_amdgcn_permlane32_swap(__float_as_uint(a), __float_as_uint(b), false, false); return __uint_as_float(rr[0]) + __uint_as_float(rr[1]); }
__device__ __forceinline__ float swap16_add(float a, float b) {
    auto rr = __builtin_amdgcn_permlane16_swap(__float_as_uint(a), __float_as_uint(b), false, false); return __uint_as_float(rr[0]) + __uint_as_float(rr[1]); }
__device__ __forceinline__ float gelu_erf(float v) { return 0.5f * v * (1.0f + erff(v * 0.70710678118654752f)); }
__device__ __forceinline__ void p6_gather(Frame& F) {
    const bf16* const U = (const bf16*)(F.ws + WS_U); const bf16* const V = (const bf16*)(F.ws + WS_V); const bf16* const H1B = (const bf16*)(F.ws + WS_XN); bf16* const H2B = (bf16*)(F.ws + WS_H2B);
    const unsigned short* const IDX = (const unsigned short*)(F.ws + WS_IDX); const float* const GATE = (const float*)(F.ws + WS_GATE); const float* const SSQ = (const float*)(F.ws + WS_SSQ);
    const int gw = F.vcu * NWAVES + F.wave, NGW = F.G * NWAVES, lane = mk_tid() & 63;
    const int myk = 8 * (lane >> 5) + 4 * ((lane >> 4) & 1) + (lane & 3);
    for (int t = gw; t < M; t += NGW) {
        const v4u xa = *((const GAS v4u*)(H1B + (size_t)t * D) + lane), xb = *((const GAS v4u*)(H1B + (size_t)t * D) + 64 + lane);
        const float rstd = 1.0f / sqrtf(SSQ[2 * M + t] * (1.f / 1024.f) + RMS_EPS);
        float y[16];
#pragma unroll
        for (int i = 0; i < 16; ++i) y[i] = 0.f;
#pragma unroll 1
        for (int h = 0; h < 8; ++h) {
            const int emine = IDX[(size_t)t * 128 + h * 16 + (lane & 15)];
            float p[16];
#pragma unroll
            for (int k = 0; k < 16; ++k) { const int e = __builtin_amdgcn_readlane(emine, k); const GAS v4u* row = (const GAS v4u*)(U + (size_t)e * D);
                const v4u ua = row[lane], ub = row[64 + lane]; p[k] = dot8bf(xb, ub, dot8bf(xa, ua, 0.f)); }
            float q8[8], q4[4];
#pragma unroll
            for (int k = 0; k < 8; ++k) q8[k] = swap32_add(p[k], p[8 + k]);
#pragma unroll
            for (int k = 0; k < 4; ++k) q4[k] = swap16_add(q8[k], q8[4 + k]);
#pragma unroll
            for (int k = 0; k < 4; ++k) { float v = q4[k]; v += __shfl_xor(v, 8); v += __shfl_xor(v, 4); v += __shfl_xor(v, 2); v += __shfl_xor(v, 1); q4[k] = v; }
            const float dotv = (lane & 2) ? ((lane & 1) ? q4[3] : q4[2]) : ((lane & 1) ? q4[1] : q4[0]);
            const float coef = GATE[(size_t)t * 128 + h * 16 + myk] * gelu_erf(dotv * rstd);
            const unsigned cb = f2bf(coef);
#pragma unroll
            for (int k = 0; k < 16; ++k) { const int e = __builtin_amdgcn_readlane(emine, k); const unsigned c = (unsigned)__builtin_amdgcn_readlane((int)cb, 32 * (k >> 3) + 16 * ((k >> 2) & 1) + (k & 3));
                const unsigned clo = c, chi = c << 16; const GAS v4u* row = (const GAS v4u*)(V + (size_t)e * D); const v4u va = row[lane], vb = row[64 + lane];
                y[0] = dot2bf(va.x, clo, y[0]); y[1] = dot2bf(va.x, chi, y[1]); y[2] = dot2bf(va.y, clo, y[2]); y[3] = dot2bf(va.y, chi, y[3]);
                y[4] = dot2bf(va.z, clo, y[4]); y[5] = dot2bf(va.z, chi, y[5]); y[6] = dot2bf(va.w, clo, y[6]); y[7] = dot2bf(va.w, chi, y[7]);
                y[8] = dot2bf(vb.x, clo, y[8]); y[9] = dot2bf(vb.x, chi, y[9]); y[10] = dot2bf(vb.y, clo, y[10]); y[11] = dot2bf(vb.y, chi, y[11]);
                y[12] = dot2bf(vb.z, clo, y[12]); y[13] = dot2bf(vb.z, chi, y[13]); y[14] = dot2bf(vb.w, clo, y[14]); y[15] = dot2bf(vb.w, chi, y[15]); }
        }
        GAS f32x4* hp = (GAS f32x4*)(F.out + (size_t)t * D); float s2 = 0.f; v4u wa, wb;
        { f32x4 a0 = hp[2 * lane], a1 = hp[2 * lane + 1]; a0 = a0 + (f32x4){y[0], y[1], y[2], y[3]}; a1 = a1 + (f32x4){y[4], y[5], y[6], y[7]}; hp[2 * lane] = a0; hp[2 * lane + 1] = a1;
          s2 += (a0.x * a0.x + a0.y * a0.y) + (a0.z * a0.z + a0.w * a0.w) + (a1.x * a1.x + a1.y * a1.y) + (a1.z * a1.z + a1.w * a1.w);
          wa.x = pk2(a0.x, a0.y); wa.y = pk2(a0.z, a0.w); wa.z = pk2(a1.x, a1.y); wa.w = pk2(a1.z, a1.w); }
        { f32x4 a0 = hp[128 + 2 * lane], a1 = hp[128 + 2 * lane + 1]; a0 = a0 + (f32x4){y[8], y[9], y[10], y[11]}; a1 = a1 + (f32x4){y[12], y[13], y[14], y[15]}; hp[128 + 2 * lane] = a0; hp[128 + 2 * lane + 1] = a1;
          s2 += (a0.x * a0.x + a0.y * a0.y) + (a0.z * a0.z + a0.w * a0.w) + (a1.x * a1.x + a1.y * a1.y) + (a1.z * a1.z + a1.w * a1.w);
          wb.x = pk2(a0.x, a0.y); wb.y = pk2(a0.z, a0.w); wb.z = pk2(a1.x, a1.y); wb.w = pk2(a1.z, a1.w); }
        *((GAS v4u*)(H2B + (size_t)t * D) + lane) = wa; *((GAS v4u*)(H2B + (size_t)t * D) + 64 + lane) = wb;
        s2 = wave_sum(s2); if (lane == 0) ((float*)(F.ws + WS_SSQ))[3 * M + t] = s2;
    }
}
__device__ __forceinline__ void p8_final(Frame& F) {
    const int lane = mk_tid() & 63;
    const int gw = F.vcu * NWAVES + F.wave, NGW = F.G * NWAVES; const float* SSQ = (const float*)(F.ws + WS_SSQ); const f32x4* gr = (const f32x4*)inptr(F, I_GFIN) + lane;
    for (int m = gw; m < M; m += NGW) { GAS f32x4* xr = (GAS f32x4*)(F.out + (size_t)m * D) + lane; const float rs = 1.0f / sqrtf(SSQ[4 * M + m] * (1.f / 1024.f) + RMS_EPS);
#pragma unroll
        for (int j = 0; j < 4; ++j) xr[64 * j] = xr[64 * j] * rs * gr[64 * j]; }
}
struct Args { const float* in[18]; float* out; unsigned char* ws; int ph_lo, ph_hi; };
__global__ void __launch_bounds__(NWAVES * 64, 2) mk_fwd(Args args) {
    extern __shared__ __attribute__((aligned(16))) unsigned char lds[];
    Frame F;
    F.lds = (LAS unsigned char*)lds;
    F.MISC = (volatile LAS unsigned*)(F.lds + MISC_OFF);
    F.wave = __builtin_amdgcn_readfirstlane((int)threadIdx.x >> 6);
    { const int t0 = mk_tid();
    F.G = gridDim.x; { const int bx = blockIdx.x; F.vcu = (F.G % 8 == 0) ? (bx % 8) * (F.G / 8) + bx / 8 : bx; }
    F.ws = args.ws; F.ctl = (gu32*)(args.ws + WS_CTL); F.out = args.out;
      for (int u = t0; u < (LDS_BYTES - LDSCTL_OFF) / 4; u += NWAVES * 64) ((LAS unsigned*)(F.lds + LDSCTL_OFF))[u] = 0u;
      __syncthreads();
      if (t0 < 18) ((LAS unsigned long long*)(F.lds + PTAB_OFF))[t0] = (unsigned long long)args.in[t0];
      __syncthreads(); }
    const int lo = args.ph_lo, hi = args.ph_hi;
    const bool multi = (hi - lo) > 1;
    XcdBarrier bar; bar.bar = (unsigned*)(F.ctl + CW_BAR); bar.x = 0; bar.st = nullptr;
    if (multi) bar = xcd_barrier_post((unsigned*)(F.ctl + CW_BAR), F.MISC + 8, F.wave);
#define IN(k) (lo <= (k) && (k) < hi)
#define BOTH(k) (IN(k) && IN((k) + 1))
#define GRID_BAR() xcd_barrier(bar, F.wave)
    bf16* const XN = (bf16*)(F.ws + WS_XN); bf16* const PROJ = (bf16*)(F.ws + WS_PROJ); bf16* const ATT = (bf16*)(F.ws + WS_ATT); bf16* const PLEB = (bf16*)(F.ws + WS_PLE);
    if (IN(0)) { p0_prologue(F); if (BOTH(0)) GRID_BAR(); }
    if (IN(1)) {
        if (blockIdx.x >= 64 && blockIdx.x < 80) p1_cumsum(F, (int)blockIdx.x - 64);
        { pg8::Gemm g{XN, (const bf16*)(F.ws + WS_WIN), M, NPROJ, D}; pg8::StaticOrder S; S.init(M, NPROJ, F.G, (int)blockIdx.x);
          pg8::EpiProj E{PROJ, (const float*)(F.ws + WS_ROPE)};
          pg8::gemm_phase<pg8::EpiProj, pg8::StaticOrder, true, true>(F.lds + RING_OFF, g, S, E, F.wave); }
        { pg8::Gemm g{(const bf16*)(F.ws + WS_PB), (const bf16*)(F.ws + WS_WPP), M, D, PLE_DIM}; pg8::StaticOrder S; S.init(M, D, 192, blockIdx.x >= 64 ? (int)blockIdx.x - 64 : (1 << 20));
          pg8::EpiBf16 E{PLEB, D};
          pg8::gemm_phase<pg8::EpiBf16, pg8::StaticOrder, true, true>(F.lds + RING_OFF, g, S, E, F.wave); }
        if (BOTH(1)) GRID_BAR();
    }
    if (IN(2)) {
        static_assert(attn_body::ATTN_LDS_BYTES <= 86016 && 86016 + 32768 <= RING_BYTES, "attention LDS map");
        const attn_body::AttnArgs AA{(const attn_body::bf16*)PROJ, (attn_body::bf16*)ATT, (const float*)(F.ws + WS_C), inptr(F, I_SINKS), (float*)(F.ws + WS_SSQ), (float*)(F.ws + WS_SSQ) + M};
        attn_body::attn_phase<8>((char*)lds + RING_OFF, AA, F.vcu, F.G, F.wave);
        if (BOTH(2)) GRID_BAR();
    }
    float* const SSQ = (float*)(F.ws + WS_SSQ);
    bf16* const H1B = (bf16*)(F.ws + WS_XN); bf16* const H2B = (bf16*)(F.ws + WS_H2B);
    if (IN(3)) {
        pg8::Gemm g{ATT, (const bf16*)(F.ws + WS_WOUT), M, D, D}; pg8::StaticOrder S; S.init(M, D, F.G, (int)blockIdx.x);
        LAS float* tab = (LAS float*)(F.lds + TAB_OFF);
        { pg8::Unit u0; const int tt = mk_tid(); if (S.next(0, u0) && tt < 256) { const int row = u0.pm * 256 + tt; const float ra = SSQ[row] * (1.f / 512.f) + RMS_EPS, rb = SSQ[M + row] * (1.f / 512.f) + RMS_EPS;
            tab[tt] = sqrtf(rb / ra); tab[256 + tt] = 1.0f / sqrtf(rb); } }
        __syncthreads();
        pg8::EpiOut E{inptr(F, I_X), F.out, H1B, (const PG8_LAS float*)tab, SSQ + 2 * M};
        pg8::gemm_phase<pg8::EpiOut, pg8::StaticOrder, true, true>(F.lds + RING_OFF, g, S, E, F.wave);
        if (BOTH(3)) GRID_BAR();
    }
    if (IN(4)) {
        pg8::Gemm g{H1B, (const bf16*)(F.ws + WS_WEFF), M, NSC, D};
        pg8::EpiTopK E{SSQ + 2 * M, (unsigned short*)(F.ws + WS_IDX), (float*)(F.ws + WS_GATE)};
#pragma unroll 1
        for (int r = 0; r < 2; ++r) { pg8::RoundOrder S; S.so.init(M, NSC, F.G, (int)blockIdx.x); S.round = r;
            pg8::gemm_phase<pg8::EpiTopK, pg8::RoundOrder, false, true>(F.lds + RING_OFF, g, S, E, F.wave); }
        if (BOTH(4)) GRID_BAR();
    }
    if (IN(5)) { p6_gather(F); if (BOTH(5)) GRID_BAR(); }
    if (IN(6)) {
        pg8::Gemm g{H2B, (const bf16*)(F.ws + WS_WPG), M, D, D}; pg8::StaticOrder S; S.init(M, D, F.G, (int)blockIdx.x);
        pg8::EpiPle E{F.out, (const bf16*)PLEB, SSQ + 3 * M, SSQ + 4 * M};
        pg8::gemm_phase<pg8::EpiPle, pg8::StaticOrder, true, true>(F.lds + RING_OFF, g, S, E, F.wave);
        if (BOTH(6)) GRID_BAR();
    }
    if (IN(7)) { p8_final(F); }
#undef IN
#undef BOTH
#undef GRID_BAR
}
static int mk_grid() {
    static int grid = 0;
    if (grid == 0) {
        int dev = 0, cus = 0, per_cu = 0;
        if (hipGetDevice(&dev) != hipSuccess || hipDeviceGetAttribute(&cus, hipDeviceAttributeMultiprocessorCount, dev) != hipSuccess) { fprintf(stderr, "kernel_launch: device query failed\n"); grid = -1; return grid; }
        if (hipFuncSetAttribute((const void*)mk_fwd, hipFuncAttributeMaxDynamicSharedMemorySize, LDS_BYTES) != hipSuccess) { fprintf(stderr, "kernel_launch: hipFuncSetAttribute failed\n"); grid = -1; return grid; }
        if (hipOccupancyMaxActiveBlocksPerMultiprocessor(&per_cu, (const void*)mk_fwd, NWAVES * 64, LDS_BYTES) != hipSuccess || per_cu < 1) { fprintf(stderr, "kernel_launch: occupancy query says %d blocks/CU\n", per_cu); grid = -1; (void)hipGetLastError(); return grid; }
        grid = cus;
        if (grid != 256) fprintf(stderr, "kernel_launch: %d CUs (built for 256)\n", grid);
    }
    return grid;
}
static void mk_launch(void* const* d_in, void* d_out, void* d_ws, hipStream_t stream, int lo, int hi) {
    const int grid = mk_grid(); if (grid < 0) return;
    Args a{}; for (int i = 0; i < 18; ++i) a.in[i] = (const float*)d_in[i];
    a.out = (float*)d_out; a.ws = (unsigned char*)d_ws; a.ph_lo = lo; a.ph_hi = hi;
    hipLaunchKernelGGL(mk_fwd, dim3(grid), dim3(NWAVES * 64), LDS_BYTES, stream, a);
    const hipError_t le = hipPeekAtLastError(); if (le != hipSuccess) fprintf(stderr, "kernel_launch: launch [%d,%d) failed: %s\n", lo, hi, hipGetErrorName(le));
}
extern "C" void kernel_launch(void* const* d_in, const int* in_sizes, int n_in, void* d_out, int out_size, void* d_ws, size_t ws_size, hipStream_t stream) {
    if (ws_size < WS_END || n_in != 18 || out_size != M * D) { fprintf(stderr, "kernel_launch: unexpected ws_size / n_in / out_size\n"); return; }
    if (hipMemsetAsync((char*)d_ws + WS_CTL, 0, CTL_ZERO_BYTES, stream) != hipSuccess) { fprintf(stderr, "kernel_launch: memset failed\n"); return; }
    mk_launch(d_in, d_out, d_ws, stream, 0, 8);
}
```

```cpp
#include <hip/hip_runtime.h>
#include <hip/hip_bf16.h>
#include <cstdio>
#include <cstdint>
#include <cmath>
__device__ __forceinline__ int mk_lane() { int l; asm volatile("v_mbcnt_lo_u32_b32 %0, -1, 0\n\tv_mbcnt_hi_u32_b32 %0, -1, %0" : "=v"(l)); return l; }
namespace pg8 {
#define PG8_LAS __attribute__((address_space(3)))
typedef unsigned short bf16_t;
typedef short bf16x8 __attribute__((ext_vector_type(8)));
typedef float f32x4 __attribute__((ext_vector_type(4)));
typedef unsigned u32x4 __attribute__((ext_vector_type(4)));
constexpr int BM = 256, BK = 64, HALF = 128, HTB = HALF * BK * 2  , STAGE_BYTES = 8 * HTB, NXCD = 8, WGM = 8;

__host__ __device__ __forceinline__ int lds_byte(int r, int c) { const int st = (r >> 4) * 2 + (c >> 5), rr = r & 15, cc = c & 31, ob = rr * 64 + cc * 2; return st * 1024 + (ob ^ (((ob >> 9) & 1) << 5)); }
__host__ __device__ __forceinline__ void stage_rc(int b, int& R, int& C) { const int st = b / 1024, sb = b % 1024, swz = sb ^ (((sb >> 9) & 1) << 5); R = (st >> 1) * 16 + swz / 64; C = (st & 1) * 32 + (swz % 64) / 2; }
__host__ __device__ __forceinline__ int perm32(int rho) { const int n = rho >> 4, i = rho & 15; return 8 * (i >> 2) + 4 * n + (i & 3); }

struct Unit { int pm, pn; };
struct Gemm { const bf16_t* A; const bf16_t* Bt; int M, N, K; };

struct StaticOrder {
    int nM, nN, nwg, G, c;
    __host__ __device__ void init(int M, int N, int G_, int c_) { nM = M / BM; nN = N / BM; nwg = nM * nN; G = G_; c = c_; }
    __host__ __device__ bool next(int i, Unit& u) const {
        const long L = (long)i * G + c; if (L >= nwg) return false;
        int wgid = (int)L; { const int q = nwg / NXCD, r = nwg % NXCD, xcd = wgid % NXCD, off = wgid / NXCD; wgid = (xcd < r ? xcd * (q + 1) : r * (q + 1) + (xcd - r) * q) + off; }
        const int nig = WGM * nN, gid = wgid / nig, fm = gid * WGM, gsz = (nM - fm) < WGM ? (nM - fm) : WGM;
        u.pm = fm + ((wgid % nig) % gsz); u.pn = (wgid % nig) / gsz; return true;
    }
    __device__ __forceinline__ void a_ready(const Unit&) const {}
    __device__ __forceinline__ void done(const Unit&) const {}
};

__device__ __forceinline__ unsigned cvt_pk_bf16(float lo, float hi) { unsigned r; asm volatile("v_cvt_pk_bf16_f32 %0, %1, %2" : "=v"(r) : "v"(lo), "v"(hi)); return r; }
typedef float f32x2 __attribute__((ext_vector_type(2)));
typedef unsigned u32x2 __attribute__((ext_vector_type(2)));
constexpr float QK_C2 = 0.125f * 1.4426950408889634f;
struct EpiBf16 {
    static constexpr bool PERM = true, AFTER_DRAIN = false, MIDSCALE = false;
    bf16_t* O; int ldc;
    __device__ __forceinline__ void operator()(const f32x4 (&acc)[2][2][4][2], const Unit& u, int wr, int wc, int fr, int fq) const {
        const int row0 = u.pm * BM + wr * 64 + fr, col0 = u.pn * BM + wc * 32 + 8 * fq;
#pragma unroll
        for (int ai = 0; ai < 2; ++ai)
#pragma unroll
            for (int m = 0; m < 4; ++m) { bf16_t* rowp = O + (size_t)(row0 + ai * HALF + m * 16) * ldc + col0;
#pragma unroll
                for (int bj = 0; bj < 2; ++bj) { const f32x4 v0 = acc[ai][bj][m][0], v1 = acc[ai][bj][m][1];
                    u32x4 w; w.x = cvt_pk_bf16(v0[0], v0[1]); w.y = cvt_pk_bf16(v0[2], v0[3]); w.z = cvt_pk_bf16(v1[0], v1[1]); w.w = cvt_pk_bf16(v1[2], v1[3]);
                    *(u32x4*)(rowp + bj * HALF) = w; } }
    }
};
struct EpiProj {
    static constexpr bool PERM = true, AFTER_DRAIN = false, MIDSCALE = false;
    bf16_t* O; const float* rope;
    __device__ __forceinline__ void operator()(const f32x4 (&acc)[2][2][4][2], const Unit& u, int wr, int wc, int fr, int fq) const {
        const int row0 = u.pm * BM + wr * 64 + fr, colb = u.pn * BM + wc * 32 + 8 * fq;
#pragma unroll
        for (int bj = 0; bj < 2; ++bj) {
            const int col = colb + bj * HALF; const bool rot = col < 640; const float sc = (col < 512 || (col >= 768 && col < 1280)) ? QK_C2 : 1.0f; const int i0 = (col & 63) >> 1;
#pragma unroll
            for (int ai = 0; ai < 2; ++ai)
#pragma unroll
                for (int m = 0; m < 4; ++m) { const int row = row0 + ai * HALF + m * 16; f32x4 v0 = acc[ai][bj][m][0], v1 = acc[ai][bj][m][1];
                    if (rot) { const f32x4* rp = (const f32x4*)(rope + ((size_t)(row & 8191) * 32 + i0) * 2); const f32x4 c0 = rp[0], c1 = rp[1];
                        const f32x4 a = v0, b = v1;
                        v0[0] = a[0] * c0[0] - a[1] * c0[1]; v0[1] = a[1] * c0[0] + a[0] * c0[1]; v0[2] = a[2] * c0[2] - a[3] * c0[3]; v0[3] = a[3] * c0[2] + a[2] * c0[3];
                        v1[0] = b[0] * c1[0] - b[1] * c1[1]; v1[1] = b[1] * c1[0] + b[0] * c1[1]; v1[2] = b[2] * c1[2] - b[3] * c1[3]; v1[3] = b[3] * c1[2] + b[2] * c1[3]; }
                    v0 = v0 * sc; v1 = v1 * sc;
                    u32x4 w; w.x = cvt_pk_bf16(v0[0], v0[1]); w.y = cvt_pk_bf16(v0[2], v0[3]); w.z = cvt_pk_bf16(v1[0], v1[1]); w.w = cvt_pk_bf16(v1[2], v1[3]);
                    *(u32x4*)(O + (size_t)row * 2304 + col) = w; }
        }
    }
};
struct PleOrder {
    int c;
    __device__ bool next(int i, Unit& u) const { if (c < 64) return false; const int L = i * 192 + (c - 64); if (L >= 256) return false; u.pm = L >> 2; u.pn = L & 3; return true; }
    __device__ __forceinline__ void a_ready(const Unit&) const {}
    __device__ __forceinline__ void done(const Unit&) const {}
};
struct EpiOut {
    static constexpr bool PERM = false, AFTER_DRAIN = false, MIDSCALE = true;
    const float* x; float* h; bf16_t* hb; const PG8_LAS float* tab; float* ssq1;
    __device__ __forceinline__ void mid(f32x4 (&acc)[2][2][4][2], const Unit& u, int wr, int wc, int fr, int fq) const {
#pragma unroll
        for (int ai = 0; ai < 2; ++ai)
#pragma unroll
            for (int m = 0; m < 4; ++m) { const float ratio = tab[ai * HALF + wr * 64 + m * 16 + fr];
#pragma unroll
                for (int bj = 0; bj < 2; ++bj)
#pragma unroll
                    for (int n = 0; n < 2; ++n) acc[ai][bj][m][n] = acc[ai][bj][m][n] * ratio; }
    }
    __device__ __forceinline__ void operator()(const f32x4 (&acc)[2][2][4][2], const Unit& u, int wr, int wc, int fr, int fq) const {
        const int col0 = u.pn * BM + wc * 32 + 4 * fq;
#pragma unroll
        for (int ai = 0; ai < 2; ++ai)
#pragma unroll
            for (int m = 0; m < 4; ++m) { const int tr = ai * HALF + wr * 64 + m * 16 + fr, row = u.pm * BM + tr; const float rb = tab[256 + tr]; const size_t off = (size_t)row * 1024 + col0; float q = 0.f;
#pragma unroll
                for (int bj = 0; bj < 2; ++bj)
#pragma unroll
                    for (int n = 0; n < 2; ++n) { const f32x4 v = *(const f32x4*)(x + off + bj * HALF + n * 16) + acc[ai][bj][m][n] * rb;
                        *(f32x4*)(h + off + bj * HALF + n * 16) = v; u32x2 w; w.x = cvt_pk_bf16(v[0], v[1]); w.y = cvt_pk_bf16(v[2], v[3]); *(u32x2*)(hb + off + bj * HALF + n * 16) = w;
                        q += (v[0] * v[0] + v[1] * v[1]) + (v[2] * v[2] + v[3] * v[3]); }
                q += __shfl_xor(q, 16); q += __shfl_xor(q, 32); if (fq == 0) unsafeAtomicAdd(ssq1 + row, q); }
    }
};
struct EpiPle {
    static constexpr bool PERM = false, AFTER_DRAIN = false, MIDSCALE = false;
    float* h; const bf16_t* ple; const float* ssq2; float* ssq3;
    __device__ __forceinline__ void operator()(const f32x4 (&acc)[2][2][4][2], const Unit& u, int wr, int wc, int fr, int fq) const {
        const int col0 = u.pn * BM + wc * 32 + 4 * fq;
#pragma unroll
        for (int ai = 0; ai < 2; ++ai)
#pragma unroll
            for (int m = 0; m < 4; ++m) { const int row = u.pm * BM + ai * HALF + wr * 64 + m * 16 + fr; const float r2 = 1.0f / sqrtf(ssq2[row] * (1.f / 1024.f) + 1e-6f); const size_t off = (size_t)row * 1024 + col0; float q = 0.f;
#pragma unroll
                for (int bj = 0; bj < 2; ++bj)
#pragma unroll
                    for (int n = 0; n < 2; ++n) { const size_t o2 = off + bj * HALF + n * 16; const f32x4 a = acc[ai][bj][m][n] * r2; const u32x2 pw = *(const u32x2*)(ple + o2); f32x4 v = *(const f32x4*)(h + o2);
                        v[0] += __uint_as_float(pw.x << 16) / (1.0f + __expf(-a[0])); v[1] += __uint_as_float(pw.x & 0xffff0000u) / (1.0f + __expf(-a[1]));
                        v[2] += __uint_as_float(pw.y << 16) / (1.0f + __expf(-a[2])); v[3] += __uint_as_float(pw.y & 0xffff0000u) / (1.0f + __expf(-a[3]));
                        *(f32x4*)(h + o2) = v; q += (v[0] * v[0] + v[1] * v[1]) + (v[2] * v[2] + v[3] * v[3]); }
                q += __shfl_xor(q, 16); q += __shfl_xor(q, 32); if (fq == 0) unsafeAtomicAdd(ssq3 + row, q); }
    }
};
#define TK_CE(a,b) { const float hi_=__builtin_fmaxf(a,b), lo_=__builtin_fminf(a,b); a=hi_; b=lo_; }
__device__ __forceinline__ void tk_sort16(float (&x)[16]) {
  TK_CE(x[0],x[1])
  TK_CE(x[2],x[3])
  TK_CE(x[0],x[2])
  TK_CE(x[1],x[3])
  TK_CE(x[1],x[2])
  TK_CE(x[4],x[5])
  TK_CE(x[6],x[7])
  TK_CE(x[4],x[6])
  TK_CE(x[5],x[7])
  TK_CE(x[5],x[6])
  TK_CE(x[0],x[4])
  TK_CE(x[2],x[6])
  TK_CE(x[2],x[4])
  TK_CE(x[1],x[5])
  TK_CE(x[3],x[7])
  TK_CE(x[3],x[5])
  TK_CE(x[1],x[2])
  TK_CE(x[3],x[4])
  TK_CE(x[5],x[6])
  TK_CE(x[8],x[9])
  TK_CE(x[10],x[11])
  TK_CE(x[8],x[10])
  TK_CE(x[9],x[11])
  TK_CE(x[9],x[10])
  TK_CE(x[12],x[13])
  TK_CE(x[14],x[15])
  TK_CE(x[12],x[14])
  TK_CE(x[13],x[15])
  TK_CE(x[13],x[14])
  TK_CE(x[8],x[12])
  TK_CE(x[10],x[14])
  TK_CE(x[10],x[12])
  TK_CE(x[9],x[13])
  TK_CE(x[11],x[15])
  TK_CE(x[11],x[13])
  TK_CE(x[9],x[10])
  TK_CE(x[11],x[12])
  TK_CE(x[13],x[14])
  TK_CE(x[0],x[8])
  TK_CE(x[4],x[12])
  TK_CE(x[4],x[8])
  TK_CE(x[2],x[10])
  TK_CE(x[6],x[14])
  TK_CE(x[6],x[10])
  TK_CE(x[2],x[4])
  TK_CE(x[6],x[8])
  TK_CE(x[10],x[12])
  TK_CE(x[1],x[9])
  TK_CE(x[5],x[13])
  TK_CE(x[5],x[9])
  TK_CE(x[3],x[11])
  TK_CE(x[7],x[15])
  TK_CE(x[7],x[11])
  TK_CE(x[3],x[5])
  TK_CE(x[7],x[9])
  TK_CE(x[11],x[13])
  TK_CE(x[1],x[2])
  TK_CE(x[3],x[4])
  TK_CE(x[5],x[6])
  TK_CE(x[7],x[8])
  TK_CE(x[9],x[10])
  TK_CE(x[11],x[12])
  TK_CE(x[13],x[14])
}
__device__ __forceinline__ void tk_clean16(float (&x)[16]) {
  TK_CE(x[0],x[8])
  TK_CE(x[1],x[9])
  TK_CE(x[2],x[10])
  TK_CE(x[3],x[11])
  TK_CE(x[4],x[12])
  TK_CE(x[5],x[13])
  TK_CE(x[6],x[14])
  TK_CE(x[7],x[15])
  TK_CE(x[0],x[4])
  TK_CE(x[1],x[5])
  TK_CE(x[2],x[6])
  TK_CE(x[3],x[7])
  TK_CE(x[8],x[12])
  TK_CE(x[9],x[13])
  TK_CE(x[10],x[14])
  TK_CE(x[11],x[15])
  TK_CE(x[0],x[2])
  TK_CE(x[1],x[3])
  TK_CE(x[4],x[6])
  TK_CE(x[5],x[7])
  TK_CE(x[8],x[10])
  TK_CE(x[9],x[11])
  TK_CE(x[12],x[14])
  TK_CE(x[13],x[15])
  TK_CE(x[0],x[1])
  TK_CE(x[2],x[3])
  TK_CE(x[4],x[5])
  TK_CE(x[6],x[7])
  TK_CE(x[8],x[9])
  TK_CE(x[10],x[11])
  TK_CE(x[12],x[13])
  TK_CE(x[14],x[15])
}
__device__ __forceinline__ void tk_merge16(float (&a)[16], const float (&b)[16]) {
#pragma unroll
  for (int i = 0; i < 16; ++i) a[i] = __builtin_fmaxf(a[i], b[15 - i]);
  tk_clean16(a);
}
#define TK_NPAIR 50
#define TK_PAIRS(X) X(0,0,0) X(1,0,1) X(2,0,2) X(3,0,3) X(4,0,4) X(5,0,5) X(6,0,6) X(7,0,7) X(8,0,8) X(9,0,9) X(10,0,10) X(11,0,11) X(12,0,12) X(13,0,13) X(14,0,14) X(15,0,15) X(16,1,0) X(17,1,1) X(18,1,2) X(19,1,3) X(20,1,4) X(21,1,5) X(22,1,6) X(23,1,7) X(24,2,0) X(25,2,1) X(26,2,2) X(27,2,3) X(28,2,4) X(29,3,0) X(30,3,1) X(31,3,2) X(32,3,3) X(33,4,0) X(34,4,1) X(35,4,2) X(36,5,0) X(37,5,1) X(38,6,0) X(39,6,1) X(40,7,0) X(41,7,1) X(42,8,0) X(43,9,0) X(44,10,0) X(45,11,0) X(46,12,0) X(47,13,0) X(48,14,0) X(49,15,0)
struct EpiTopK {
    static constexpr bool PERM = false, AFTER_DRAIN = true, MIDSCALE = false;
    const float* ssq1; unsigned short* idx; float* gate;
    __device__ __forceinline__ void fused(f32x4 (&acc)[2][2][4][2], const Unit& u, int wr, int wc, int fr, int fq, PG8_LAS unsigned char* lds, int wid, int lane) const {
        constexpr int TP = 260;
        PG8_LAS float* T = (PG8_LAS float*)lds;
        PG8_LAS float* L1 = (PG8_LAS float*)lds;
        PG8_LAS float* MG = (PG8_LAS float*)(lds + 32768);
        PG8_LAS unsigned char* PT = (PG8_LAS unsigned char*)(lds + 49152);
        const int tid = wid * 64 + lane;
#pragma unroll 1
        for (int ai = 0; ai < 2; ++ai) {
#pragma unroll
            for (int m = 0; m < 4; ++m)
#pragma unroll
                for (int bj = 0; bj < 2; ++bj)
#pragma unroll
                    for (int n = 0; n < 2; ++n) { const f32x4 v = ai == 0 ? acc[0][bj][m][n] : acc[1][bj][m][n]; *(PG8_LAS f32x4*)(T + (wr * 64 + m * 16 + fr) * TP + bj * 128 + wc * 32 + n * 16 + 4 * fq) = v; }
            asm volatile("s_waitcnt lgkmcnt(0)" ::: "memory"); __builtin_amdgcn_s_barrier(); asm volatile("" ::: "memory");
            float x[4][16];
            { const int row = tid & 127, cq = tid >> 7; const PG8_LAS f32x4* src = (const PG8_LAS f32x4*)(T + row * TP + cq * 64);
#pragma unroll
              for (int g = 0; g < 4; ++g)
#pragma unroll
                  for (int e = 0; e < 4; ++e) { const f32x4 v = src[g * 4 + e];
#pragma unroll
                      for (int j = 0; j < 4; ++j) x[g][e * 4 + j] = __uint_as_float((__float_as_uint(v[j]) & ~127u) | (unsigned)((cq & 1) * 64 + g * 16 + e * 4 + j)); } }
            asm volatile("s_waitcnt lgkmcnt(0)" ::: "memory"); __builtin_amdgcn_s_barrier(); asm volatile("" ::: "memory");
            tk_sort16(x[0]); tk_sort16(x[1]); tk_sort16(x[2]); tk_sort16(x[3]);
            tk_merge16(x[0], x[1]); tk_merge16(x[2], x[3]); tk_merge16(x[0], x[2]);
            { PG8_LAS f32x4* dst = (PG8_LAS f32x4*)(L1 + ((tid & 127) * 4 + (tid >> 7)) * 16);
#pragma unroll
              for (int e = 0; e < 4; ++e) dst[e] = (f32x4){x[0][4 * e], x[0][4 * e + 1], x[0][4 * e + 2], x[0][4 * e + 3]}; }
            if (tid < 64) { unsigned char v = 0;
#define TK_PT(p, i, j) if (tid == p) v = (unsigned char)(i | (j << 4));
                TK_PAIRS(TK_PT)
#undef TK_PT
                PT[tid] = v; }
            asm volatile("s_waitcnt lgkmcnt(0)" ::: "memory"); __builtin_amdgcn_s_barrier(); asm volatile("" ::: "memory");
            if (tid < 128) {
                const int row = tid; const int grow = u.pm * BM + ai * HALF + row;
                float a[16], b[16], t2[16];
                { const PG8_LAS f32x4* s0 = (const PG8_LAS f32x4*)(L1 + (row * 4 + 0) * 16);
#pragma unroll
                  for (int e = 0; e < 4; ++e) { const f32x4 v0 = s0[e], v1 = s0[4 + e], v2 = s0[8 + e], v3 = s0[12 + e];
#pragma unroll
                      for (int j = 0; j < 4; ++j) { a[4 * e + j] = v0[j]; t2[4 * e + j] = v1[j]; b[4 * e + j] = v2[j]; x[3][4 * e + j] = v3[j]; } } }
                tk_merge16(a, t2); tk_merge16(b, x[3]);
                { PG8_LAS f32x4* d = (PG8_LAS f32x4*)(MG + row * 32);
#pragma unroll
                  for (int e = 0; e < 4; ++e) { d[e] = (f32x4){a[4 * e], a[4 * e + 1], a[4 * e + 2], a[4 * e + 3]}; d[4 + e] = (f32x4){b[4 * e], b[4 * e + 1], b[4 * e + 2], b[4 * e + 3]}; } }
#pragma unroll
                for (int g = 0; g < 4; ++g)
#pragma unroll
                    for (int e = 0; e < 16; ++e) x[g][e] = __uint_as_float(0xff000000u | (unsigned)(g * 16 + e));
#define TK_CAND(p, i, j) x[(p) >> 4][(p) & 15] = __uint_as_float((__float_as_uint(a[i] + b[j]) & ~63u) | (unsigned)(p));
                TK_PAIRS(TK_CAND)
#undef TK_CAND
                tk_sort16(x[0]); tk_sort16(x[1]); tk_sort16(x[2]); tk_sort16(x[3]);
                tk_merge16(x[0], x[1]); tk_merge16(x[2], x[3]); tk_merge16(x[0], x[2]);
                const float rs = 1.0f / sqrtf(ssq1[grow] * (1.f / 1024.f) + 1e-6f);
                float ex[16], sum = 0.f;
#pragma unroll
                for (int r = 0; r < 16; ++r) { ex[r] = __expf((x[0][r] - x[0][0]) * rs); sum += ex[r]; }
                const float inv = 1.0f / sum;
                asm volatile("s_waitcnt lgkmcnt(0)" ::: "memory");
                unsigned short* ip = idx + (size_t)grow * 128 + u.pn * 16; float* gp = gate + (size_t)grow * 128 + u.pn * 16;
                unsigned ew[8];
#pragma unroll
                for (int r = 0; r < 16; ++r) { const unsigned pid = __float_as_uint(x[0][r]) & 63u; const unsigned ij = PT[pid];
                    const unsigned ka = __float_as_uint(MG[row * 32 + (ij & 15u)]) & 127u, kb = __float_as_uint(MG[row * 32 + 16 + (ij >> 4)]) & 127u; const unsigned e = ka * 128u + kb;
                    if (r & 1) ew[r >> 1] |= e << 16; else ew[r >> 1] = e; }
                *(u32x4*)ip = (u32x4){ew[0], ew[1], ew[2], ew[3]}; *(u32x4*)(ip + 8) = (u32x4){ew[4], ew[5], ew[6], ew[7]};
#pragma unroll
                for (int e = 0; e < 4; ++e) *(f32x4*)(gp + 4 * e) = (f32x4){ex[4 * e] * inv, ex[4 * e + 1] * inv, ex[4 * e + 2] * inv, ex[4 * e + 3] * inv};
            }
            asm volatile("s_waitcnt lgkmcnt(0)" ::: "memory"); __builtin_amdgcn_s_barrier(); asm volatile("" ::: "memory");
        }
    }
};
struct RoundOrder {
    StaticOrder so; int round;
    __device__ bool next(int i, Unit& u) const { return i == 0 && so.next(round, u); }
    __device__ __forceinline__ void a_ready(const Unit&) const {}
    __device__ __forceinline__ void done(const Unit&) const {}
};
template <class Epi, class Sched, bool ALIGN_EPI = false, bool SP2 = false>
__device__ __forceinline__ void gemm_phase(PG8_LAS unsigned char* lds, const Gemm g, const Sched& S, const Epi& E, const int MKW) {
    const int wid = MKW, lane = mk_lane(), tid = wid * 64 + lane, wr = wid >> 2, wc = wid & 3, fr = lane & 15, fq = lane >> 4;
    const int K = g.K, nt = K / BK;
    unsigned voffA[2], voffB[2];
#pragma unroll
    for (int i = 0; i < 2; ++i) { int R, C; stage_rc(tid * 16 + i * 8192, R, C); const int Rb = Epi::PERM ? ((R & ~31) + perm32(R & 31)) : R;
        voffA[i] = (unsigned)(R * K + C) * 2u; voffB[i] = (unsigned)(Rb * K + C) * 2u; }
    const size_t kstep = (size_t)(BK * 2);
    const size_t hstep = (size_t)HALF * K * 2;
    const size_t tstep = 2 * hstep;
    const unsigned ldsw = (unsigned)wid * 1024u;
    const int aoff = lds_byte(wr * 64 + fr, fq * 8), boff = lds_byte(wc * 32 + fr, fq * 8);
#define PG8_SA(b, h) (((b) * 2 + (h)) * HTB)
#define PG8_SB(b, h) ((4 + (b) * 2 + (h)) * HTB)
#define PG8_STAGE(bufoff, gbase, voff) do { _Pragma("unroll") for (int _i = 0; _i < 2; ++_i) \
        __builtin_amdgcn_global_load_lds((const unsigned*)((const char*)(gbase) + (voff)[_i]), (PG8_LAS unsigned*)(lds + (bufoff) + ldsw + _i * 8192), 16, 0, 0); } while (0)
#define PG8_LDA(dst, b, h) do { _Pragma("unroll") for (int m = 0; m < 4; ++m) _Pragma("unroll") for (int k = 0; k < 2; ++k) dst[m][k] = *(const PG8_LAS bf16x8*)(lds + PG8_SA(b, h) + aoff + m * 2048 + k * 1024); } while (0)
#define PG8_LDB(dst, b, h) do { _Pragma("unroll") for (int n = 0; n < 2; ++n) _Pragma("unroll") for (int k = 0; k < 2; ++k) dst[n][k] = *(const PG8_LAS bf16x8*)(lds + PG8_SB(b, h) + boff + n * 2048 + k * 1024); } while (0)
#define PG8_MMA(ai, bj, At, Bt) do { __builtin_amdgcn_s_setprio(1); _Pragma("unroll") for (int m = 0; m < 4; ++m) _Pragma("unroll") for (int n = 0; n < 2; ++n) _Pragma("unroll") for (int k = 0; k < 2; ++k) \
        acc[ai][bj][m][n] = __builtin_amdgcn_mfma_f32_16x16x32_bf16(Bt[n][k], At[m][k], acc[ai][bj][m][n], 0, 0, 0); __builtin_amdgcn_s_setprio(0); } while (0)
#define PG8_WAIT_V(n) asm volatile("s_waitcnt vmcnt(" #n ")" ::: "memory")
#define PG8_WAIT_L(n) asm volatile("s_waitcnt lgkmcnt(" #n ")" ::: "memory")
#define PG8_BAR __builtin_amdgcn_s_barrier()
#define PG8_SCHED __builtin_amdgcn_sched_barrier(0)
    Unit cur, nxt; int ui = 0;
    if (!S.next(0, cur)) return;
    f32x4 acc[2][2][4][2];
#pragma unroll
    for (int a = 0; a < 2; ++a)
#pragma unroll
        for (int b = 0; b < 2; ++b)
#pragma unroll
            for (int m = 0; m < 4; ++m)
#pragma unroll
                for (int n = 0; n < 2; ++n) acc[a][b][m][n] = (f32x4){0.f, 0.f, 0.f, 0.f};
    bf16x8 At[4][2], B0[2][2], B1[2][2];
    const char* cA = (const char*)g.A + (size_t)cur.pm * tstep; const char* cB = (const char*)g.Bt + (size_t)cur.pn * tstep;
    S.a_ready(cur);
    if constexpr (SP2) {
        PG8_STAGE(PG8_SB(0, 0), cB, voffB); PG8_STAGE(PG8_SB(0, 1), cB + hstep, voffB); PG8_STAGE(PG8_SA(0, 0), cA, voffA); PG8_STAGE(PG8_SA(0, 1), cA + hstep, voffA);
        if (wr == 1) PG8_BAR;
        PG8_WAIT_V(2); PG8_BAR;
        PG8_STAGE(PG8_SB(1, 0), cB + kstep, voffB); PG8_STAGE(PG8_SA(1, 0), cA + kstep, voffA); PG8_STAGE(PG8_SB(1, 1), cB + hstep + kstep, voffB);
        PG8_WAIT_V(6); PG8_BAR;
    } else {
        PG8_STAGE(PG8_SB(0, 0), cB, voffB); PG8_STAGE(PG8_SA(0, 0), cA, voffA); PG8_STAGE(PG8_SB(0, 1), cB + hstep, voffB); PG8_STAGE(PG8_SA(0, 1), cA + hstep, voffA);
        if (wr == 1) PG8_BAR;
        PG8_WAIT_V(4); PG8_BAR;
        PG8_STAGE(PG8_SB(1, 0), cB + kstep, voffB); PG8_STAGE(PG8_SA(1, 0), cA + kstep, voffA); PG8_STAGE(PG8_SB(1, 1), cB + hstep + kstep, voffB);
        PG8_WAIT_V(6); PG8_BAR;
    }
    for (;;) {
        const bool has_next = S.next(ui + 1, nxt);
        const char* nA = has_next ? (const char*)g.A + (size_t)nxt.pm * tstep : cA; const char* nB = has_next ? (const char*)g.Bt + (size_t)nxt.pn * tstep : cB;
        for (int t = 0; t < nt; t += 2) {
            const bool last = (t == nt - 2);
            if constexpr (Epi::MIDSCALE) { if (t == (nt >> 1)) E.mid(acc, cur, wr, wc, fr, fq); }
            const char* a1 = cA + (size_t)(t + 1) * kstep;
            const char* a2 = last ? nA : cA + (size_t)(t + 2) * kstep; const char* b2 = last ? nB : cB + (size_t)(t + 2) * kstep;
            const char* a3 = a2 + kstep; const char* b3 = b2 + kstep;
            if (last && has_next) S.a_ready(nxt);
            if constexpr (SP2) {
            PG8_LDB(B0, 0, 0); PG8_LDB(B1, 0, 1); PG8_SCHED; PG8_LDA(At, 0, 0); PG8_STAGE(PG8_SA(1, 1), a1 + hstep, voffA);
            PG8_WAIT_V(8); PG8_WAIT_L(0); PG8_BAR; PG8_MMA(0, 0, At, B0); PG8_MMA(0, 1, At, B1); PG8_BAR; PG8_SCHED;
            PG8_LDA(At, 0, 1); PG8_STAGE(PG8_SB(0, 0), b2, voffB); PG8_STAGE(PG8_SB(0, 1), b2 + hstep, voffB); PG8_STAGE(PG8_SA(0, 0), a2, voffA);
            PG8_WAIT_V(8); PG8_WAIT_L(0); PG8_BAR; PG8_MMA(1, 0, At, B0); PG8_MMA(1, 1, At, B1); PG8_BAR; PG8_SCHED;
            PG8_LDB(B0, 1, 0); PG8_LDB(B1, 1, 1); PG8_SCHED; PG8_LDA(At, 1, 0); PG8_STAGE(PG8_SA(0, 1), a2 + hstep, voffA);
            PG8_WAIT_V(8); PG8_WAIT_L(0); PG8_BAR; PG8_MMA(0, 0, At, B0); PG8_MMA(0, 1, At, B1); PG8_BAR; PG8_SCHED;
            PG8_LDA(At, 1, 1); PG8_STAGE(PG8_SB(1, 0), b3, voffB); PG8_STAGE(PG8_SB(1, 1), b3 + hstep, voffB); PG8_STAGE(PG8_SA(1, 0), a3, voffA);
            PG8_WAIT_V(8); PG8_WAIT_L(0); PG8_BAR; PG8_MMA(1, 0, At, B0); PG8_MMA(1, 1, At, B1); PG8_BAR; PG8_SCHED;
            } else {
            PG8_LDB(B0, 0, 0); PG8_SCHED; PG8_LDA(At, 0, 0); PG8_STAGE(PG8_SA(1, 1), a1 + hstep, voffA);
            PG8_WAIT_L(8); PG8_BAR; PG8_WAIT_L(0); PG8_MMA(0, 0, At, B0); PG8_BAR; PG8_SCHED;
            PG8_LDB(B1, 0, 1); PG8_STAGE(PG8_SB(0, 0), b2, voffB);
            PG8_BAR; PG8_WAIT_L(0); PG8_MMA(0, 1, At, B1); PG8_BAR;
            PG8_LDA(At, 0, 1); PG8_STAGE(PG8_SA(0, 0), a2, voffA);
            PG8_BAR; PG8_WAIT_L(0); PG8_MMA(1, 0, At, B0); PG8_BAR; PG8_SCHED;
            PG8_STAGE(PG8_SB(0, 1), b2 + hstep, voffB);
            PG8_WAIT_V(6); PG8_BAR; PG8_MMA(1, 1, At, B1); PG8_BAR;
            PG8_LDB(B0, 1, 0); PG8_SCHED; PG8_LDA(At, 1, 0); PG8_STAGE(PG8_SA(0, 1), a2 + hstep, voffA);
            PG8_WAIT_L(8); PG8_BAR; PG8_WAIT_L(0); PG8_MMA(0, 0, At, B0); PG8_BAR; PG8_SCHED;
            PG8_LDB(B1, 1, 1); PG8_STAGE(PG8_SB(1, 0), b3, voffB);
            PG8_BAR; PG8_WAIT_L(0); PG8_MMA(0, 1, At, B1); PG8_BAR;
            PG8_LDA(At, 1, 1); PG8_STAGE(PG8_SA(1, 0), a3, voffA);
            PG8_BAR; PG8_WAIT_L(0); PG8_MMA(1, 0, At, B0); PG8_BAR; PG8_SCHED;
            PG8_STAGE(PG8_SB(1, 1), b3 + hstep, voffB);
            PG8_WAIT_V(6); PG8_BAR; PG8_MMA(1, 1, At, B1); PG8_BAR;
            }
        }
        if constexpr (ALIGN_EPI) { if (wr == 0) PG8_BAR; }
        if constexpr (!Epi::AFTER_DRAIN) { E(acc, cur, wr, wc, fr, fq); S.done(cur); }
        if (!has_next) break;
#pragma unroll
        for (int a = 0; a < 2; ++a)
#pragma unroll
            for (int b = 0; b < 2; ++b)
#pragma unroll
                for (int m = 0; m < 4; ++m)
#pragma unroll
                    for (int n = 0; n < 2; ++n) acc[a][b][m][n] = (f32x4){0.f, 0.f, 0.f, 0.f};
        cur = nxt; cA = nA; cB = nB; ++ui;
        if constexpr (ALIGN_EPI) { if (wr == 1) PG8_BAR; }
    }
    PG8_WAIT_V(0);
    if constexpr (!ALIGN_EPI) { if (wr == 0) PG8_BAR; }
    PG8_BAR;
    if constexpr (Epi::AFTER_DRAIN) { E.fused(acc, cur, wr, wc, fr, fq, lds, wid, lane); S.done(cur); }
#undef PG8_SA
#undef PG8_SB
#undef PG8_STAGE
#undef PG8_LDA
#undef PG8_LDB
#undef PG8_MMA
#undef PG8_WAIT_V
#undef PG8_WAIT_L
#undef PG8_BAR
#undef PG8_SCHED
}
}
namespace attn_body {
using bf16=__hip_bfloat16;
using bf16x8=__attribute__((ext_vector_type(8)))short;
using s16x4=__attribute__((ext_vector_type(4)))short;
using f32x16=__attribute__((ext_vector_type(16)))float;
using u32x4=__attribute__((ext_vector_type(4)))unsigned;
using f32x4_t=__attribute__((ext_vector_type(4)))float;
constexpr int BATCH=2,NHEAD=8,SEQ=8192,D=64,DMQ=2304,DMO=1024;
constexpr int NW=8,QBLK=32,QB=QBLK*NW,KVBLK=64,NQB=SEQ/QB;
constexpr int ATTN_UNIT_ROWS=QB;
__device__ __forceinline__ int crow(int r,int hi){return (r&3)+8*(r>>2)+4*hi;}
#define SBAR() __builtin_amdgcn_sched_barrier(0)
__device__ __forceinline__ void cmask(f32x16&p0,f32x16&p1,int jb,int qrel,int hi){
  const float NEG=-INFINITY; int kb=64*jb+4*hi;
  #pragma unroll
  for(int r=0;r<16;++r){int kv=kb+(r&3)+8*(r>>2); if(kv>qrel)p0[r]=NEG; if(kv+32>qrel)p1[r]=NEG;}
}

constexpr int NSLOT=3, SLOTB=8192;
constexpr int LDS_K=0, LDS_V=NSLOT*SLOTB, LDS_WS=2*NSLOT*SLOTB, LDS_OST=LDS_WS+NW*64*4, LDS_BYTES=LDS_OST+NW*4096;
constexpr float C2=0.125f*1.4426950408889634f;
__device__ __forceinline__ void glds16(const void*gsrc,unsigned lds_dst){unsigned keep;
  asm volatile("s_mov_b32 %0, m0\n\ts_mov_b32 m0, %2\n\ts_nop 0\n\tglobal_load_lds_dwordx4 %1, off\n\ts_mov_b32 m0, %0":"=&s"(keep):"v"(gsrc),"s"(lds_dst):"memory");}
__device__ __forceinline__ float max3f(float a,float b,float c){float r;asm("v_max3_f32 %0, %1, %2, %3":"=v"(r):"v"(a),"v"(b),"v"(c));return r;}
__device__ __forceinline__ float max2f(float a,float b){float r;asm("v_max_f32_e32 %0, %1, %2":"=v"(r):"v"(a),"v"(b));return r;}
__device__ __forceinline__ float fadd_s(float a,float b){float r;asm("v_add_f32_e32 %0, %1, %2":"=v"(r):"v"(a),"v"(b));return r;}
__device__ __forceinline__ float fsub_s(float a,float b){float r;asm("v_sub_f32_e32 %0, %1, %2":"=v"(r):"v"(a),"v"(b));return r;}
typedef float f32x2_t __attribute__((ext_vector_type(2))); typedef __bf16 bf16x2_t __attribute__((ext_vector_type(2)));
__device__ __forceinline__ unsigned cvtpk_s(float lo,float hi){f32x2_t v={lo,hi};bf16x2_t b=__builtin_convertvector(v,bf16x2_t);return __builtin_bit_cast(unsigned,b);}
#define WAIT_BAR(N) asm volatile("s_waitcnt vmcnt(" #N ") lgkmcnt(0)\n\ts_barrier":::"memory")

__device__ __forceinline__ void qkt(f32x16&p0,f32x16&p1,const char*Kslot,const bf16x8*qr,const f32x16 cin0,const f32x16 cin1,int r32,int hi){
  const char*kb=Kslot+hi*1024+r32*16;
  #pragma unroll
  for(int d0=0;d0<4;++d0){
    const bf16x8 b0=*reinterpret_cast<const bf16x8*>(kb+d0*2048);
    const bf16x8 b1=*reinterpret_cast<const bf16x8*>(kb+d0*2048+512);
    if(d0==0){p0=__builtin_amdgcn_mfma_f32_32x32x16_bf16(b0,qr[0],cin0,0,0,0);p1=__builtin_amdgcn_mfma_f32_32x32x16_bf16(b1,qr[0],cin1,0,0,0);}
    else{p0=__builtin_amdgcn_mfma_f32_32x32x16_bf16(b0,qr[d0],p0,0,0,0);p1=__builtin_amdgcn_mfma_f32_32x32x16_bf16(b1,qr[d0],p1,0,0,0);}}
}
typedef __attribute__((address_space(3))) const char* lds_cptr;
typedef short v4i16_t __attribute__((ext_vector_type(4)));
__device__ __forceinline__ void kload8(bf16x8*kf,lds_cptr kp){
  kf[0]=*(const __attribute__((address_space(3))) bf16x8*)(kp);      kf[1]=*(const __attribute__((address_space(3))) bf16x8*)(kp+512);
  kf[2]=*(const __attribute__((address_space(3))) bf16x8*)(kp+2048); kf[3]=*(const __attribute__((address_space(3))) bf16x8*)(kp+2560);
  kf[4]=*(const __attribute__((address_space(3))) bf16x8*)(kp+4096); kf[5]=*(const __attribute__((address_space(3))) bf16x8*)(kp+4608);
  kf[6]=*(const __attribute__((address_space(3))) bf16x8*)(kp+6144); kf[7]=*(const __attribute__((address_space(3))) bf16x8*)(kp+6656);
}
__device__ __forceinline__ void kload2(bf16x8*kf,lds_cptr kp,int j){ kf[2*j]=*(const __attribute__((address_space(3))) bf16x8*)(kp+j*2048); kf[2*j+1]=*(const __attribute__((address_space(3))) bf16x8*)(kp+j*2048+512); }
__device__ __forceinline__ s16x4 vtr(lds_cptr p){ return __builtin_bit_cast(s16x4,__builtin_amdgcn_ds_read_tr16_b64_v4i16((__attribute__((address_space(3))) v4i16_t*)p)); }
__device__ __forceinline__ float rowmax(const f32x16&p0,const f32x16&p1){
  float a=max3f(p0[0],p0[1],p1[0]),b=max3f(p0[2],p0[3],p1[1]);a=max3f(a,p1[2],p1[3]);
  #pragma unroll
  for(int r=4;r<16;r+=4){a=max3f(a,p0[r],p0[r+1]);b=max3f(b,p0[r+2],p0[r+3]);a=max3f(a,p1[r],p1[r+1]);b=max3f(b,p1[r+2],p1[r+3]);}
  const float m=max2f(a,b);
  auto rr=__builtin_amdgcn_permlane32_swap(__float_as_uint(m),__float_as_uint(m),false,false);
  return max2f(__uint_as_float(rr[0]),__uint_as_float(rr[1]));
}
__device__ __forceinline__ void pv(f32x16*o,int vb,bf16x8 pa0,bf16x8 pa1,bf16x8 pa2,bf16x8 pa3){
  #pragma unroll
  for(int d0=0;d0<2;++d0){s16x4 lo[4],hi[4];
    #pragma unroll
    for(int ks=0;ks<4;++ks){
      asm volatile("ds_read_b64_tr_b16 %0,%1 offset:%c2":"=&v"(lo[ks]):"v"(vb),"i"(d0*4096+ks*1024):"memory");
      asm volatile("ds_read_b64_tr_b16 %0,%1 offset:%c2":"=&v"(hi[ks]):"v"(vb),"i"(d0*4096+ks*1024+512):"memory");}
    asm volatile("s_waitcnt lgkmcnt(0)":::"memory");SBAR();
    #define PK(k) (bf16x8){lo[k][0],lo[k][1],lo[k][2],lo[k][3],hi[k][0],hi[k][1],hi[k][2],hi[k][3]}
    o[d0]=__builtin_amdgcn_mfma_f32_32x32x16_bf16(pa0,PK(0),o[d0],0,0,0);
    o[d0]=__builtin_amdgcn_mfma_f32_32x32x16_bf16(pa1,PK(1),o[d0],0,0,0);
    o[d0]=__builtin_amdgcn_mfma_f32_32x32x16_bf16(pa2,PK(2),o[d0],0,0,0);
    o[d0]=__builtin_amdgcn_mfma_f32_32x32x16_bf16(pa3,PK(3),o[d0],0,0,0);
    #undef PK
  }
}

#ifndef ATTN_STORE16
#define ATTN_STORE16(p,v) (*(u32x4*)(p)=(v))
#endif
typedef __attribute__((address_space(3))) const float* lds_fptr;
template<int THRL> __device__ __forceinline__ void attn_unit(int b,int h,int qb,const bf16*Q,const bf16*__restrict__ K,const bf16*__restrict__ V,bf16*O,char*shm,lds_fptr cl,float*ssq,const int MKW){
  const int lane=mk_lane(),r32=lane&31,hi=lane>>5; const int wid=MKW;
  const long rowbase=(long)b*SEQ; const int q0=qb*QB;
  const bf16*Qw=Q+(rowbase+q0+wid*QBLK)*DMQ+h*D;
  const bf16*Kh=K+rowbase*DMQ+h*D,*Vh=V+rowbase*DMQ+h*D;
  const unsigned lds0=(unsigned)(uintptr_t)shm;
  float*wsf=(float*)(shm+LDS_WS)+wid*64;
  const bf16*ksrc=Kh+(long)lane*DMQ+wid*8;
  const bf16*vsrc=Vh+(long)(16*(wid&3)+(lane>>2))*DMQ+(wid>>2)*32+(lane&3)*8;
  const unsigned kdst=lds0+LDS_K+wid*1024, vdst=lds0+LDS_V+wid*1024;
  #define DMA_K(t,slot) glds16(ksrc+(long)(t)*KVBLK*DMQ,(unsigned)__builtin_amdgcn_readfirstlane(kdst+(slot)))
  #define DMA_V(t,slot) glds16(vsrc+(long)(t)*KVBLK*DMQ,(unsigned)__builtin_amdgcn_readfirstlane(vdst+(slot)))
  const int vb0=(int)(lds0+LDS_V)+((lane>>4)&1)*32+(lane&3)*8+(4*hi+((lane&15)>>2))*64;
  const char*Kbase=shm+LDS_K; bf16x8 kf[8];
  const lds_cptr shm3=(lds_cptr)shm; const lds_cptr kp0=shm3+LDS_K+hi*1024+r32*16; const lds_cptr vp0=shm3+LDS_V+((lane>>4)&1)*32+(lane&3)*8+(4*hi+((lane&15)>>2))*64;
  const int NT=(q0+QB)/KVBLK;
  DMA_K(0,0);DMA_V(0,0);DMA_K(1,SLOTB);
  bf16x8 qr[4];
  #pragma unroll
  for(int d0=0;d0<4;++d0)qr[d0]=*reinterpret_cast<const bf16x8*>(&Qw[(long)r32*DMQ+d0*16+hi*8]);
  const int qrel=wid*QBLK+r32;
  #define cq (cl[q0+qrel])
  float mhat=0.f,l_reg=0.f;f32x16 o[2];o[0]=f32x16{};o[1]=f32x16{};
  float dmq=cq;
  #define PREP_LD(P0,P1,t) do{ const __attribute__((address_space(3))) f32x4_t* cp_=(const __attribute__((address_space(3))) f32x4_t*)(cl+64*(t)+4*hi); \
    _Pragma("unroll") for(int g_=0;g_<4;++g_){ const f32x4_t a_=cp_[2*g_], b_=cp_[8+2*g_]; \
      _Pragma("unroll") for(int j_=0;j_<4;++j_){ P0[4*g_+j_]=a_[j_]; P1[4*g_+j_]=b_[j_]; } } }while(0)
  #define PREP_SUB(P0,P1) do{ _Pragma("unroll") for(int r_=0;r_<16;++r_){ P0[r_]=dmq-P0[r_]; P1[r_]=dmq-P1[r_]; } }while(0)
  #define CMASK(P0,P1,t) do{int jb_=(t)-(NT-4); if(jb_>=0)cmask(P0,P1,jb_,qrel,hi);}while(0)
  bool resc=false;
  #define START(P0,P1) do{ const float rm=rowmax(P0,P1); resc=false; \
    { const float dl=rm; mhat=fadd_s(mhat,dl); \
      _Pragma("unroll") for(int r=0;r<16;++r){P0[r]=fsub_s(P0[r],dl);P1[r]=fsub_s(P1[r],dl);} \
      dmq=cq-mhat; } \
    _Pragma("unroll") for(int r=0;r<16;++r)P0[r]=__builtin_amdgcn_exp2f(P0[r]); }while(0)
  #define RESC() do{ if(resc){ asm volatile("s_waitcnt lgkmcnt(0)":::"memory"); \
      _Pragma("unroll") for(int d_=0;d_<2;++d_) _Pragma("unroll") for(int r=0;r<16;++r)o[d_][r]*=wsf[crow(r,hi)]; } }while(0)
  int sl_prev=0,sl_cur=0,sl_next=SLOTB;
  #define ROT() do{sl_prev=sl_cur;sl_cur=sl_next;sl_next=(sl_next==(NSLOT-1)*SLOTB)?0:sl_next+SLOTB;}while(0)
  DMA_K(2,2*SLOTB);
  WAIT_BAR(3);
  f32x16 pA0,pA1,pB0,pB1;
  PREP_LD(pA0,pA1,0); PREP_SUB(pA0,pA1);
  qkt(pA0,pA1,Kbase,qr,pA0,pA1,r32,hi);asm volatile("s_nop 15\n\ts_nop 7":"+v"(pA0),"+v"(pA1));CMASK(pA0,pA1,0);
  START(pA0,pA1);
  _Pragma("unroll") for(int r=0;r<16;++r)pA1[r]=__builtin_amdgcn_exp2f(pA1[r]);
  PREP_LD(pB0,pB1,1); PREP_SUB(pB0,pB1);
  WAIT_BAR(0);
  DMA_K(3,0);DMA_V(1,SLOTB);
  ROT();
  kload8(kf,kp0+sl_cur);
  WAIT_BAR(2);
  s16x4 vlo[8],vhi[8]; u32x4 pw0,pw1,pw2,pw3;
  #define PKW(P,B) cvtpk_s(P[B],P[B+1])
  #define PAF(k) __builtin_bit_cast(bf16x8,pw##k)
  #define VFR(i) (bf16x8){vlo[i][0],vlo[i][1],vlo[i][2],vlo[i][3],vhi[i][0],vhi[i][1],vhi[i][2],vhi[i][3]}
  #define PIN(x) asm volatile("":"+v"(x))
  #define MX3(a,b,c) __builtin_fmaxf(__builtin_fmaxf((a),(b)),(c))
  #define GAPA(MF,A0,A1,A2,A3,W0,W1,PW) do{ MF; sacc+=A0; sacc+=A1; sacc+=A2; sacc+=A3; PIN(sacc); W0; W1; PIN(PW); SBAR(); }while(0)
  #define EX(v) __builtin_amdgcn_exp2f(v)
  #define GAPB(MF,X,B) do{ MF; X[B]=EX(X[B]); X[B+1]=EX(X[B+1]); X[B+2]=EX(X[B+2]); X[B+3]=EX(X[B+3]); PIN(X); SBAR(); }while(0)
  #define VRD(i) do{ vlo[i]=vtr(vp_+(((i)>>2)*4096+((i)&3)*1024)); vhi[i]=vtr(vp_+(((i)>>2)*4096+((i)&3)*1024+512)); }while(0)
  #define KRD(G,j) do{ if(G){ kload2(kf,kp0+sl_next,j); SBAR(); } }while(0)
  #define STEP(C0,C1,P0,P1,t,GK,GV,GL) do{ SBAR(); \
    const lds_cptr vp_=vp0+sl_prev; \
    VRD(0); SBAR(); float sacc=(P0[0]+P0[1]); \
    GAPA(C0=__builtin_amdgcn_mfma_f32_32x32x16_bf16(kf[0],qr[0],C0,0,0,0), P0[2],P0[3],P0[4],P0[5],     pw0[0]=PKW(P0,0), pw0[1]=PKW(P0,2), pw0); \
    VRD(4); SBAR(); GAPA(C1=__builtin_amdgcn_mfma_f32_32x32x16_bf16(kf[1],qr[0],C1,0,0,0), P0[6],P0[7],P0[8],P0[9],     pw0[2]=PKW(P0,4), pw0[3]=PKW(P0,6), pw0); \
    VRD(1); SBAR(); GAPA(C0=__builtin_amdgcn_mfma_f32_32x32x16_bf16(kf[2],qr[1],C0,0,0,0),   P0[10],P0[11],P0[12],P0[13], pw1[0]=PKW(P0,8), pw1[1]=PKW(P0,10), pw1); \
    VRD(5); SBAR(); GAPA(C1=__builtin_amdgcn_mfma_f32_32x32x16_bf16(kf[3],qr[1],C1,0,0,0),   P0[14],P0[15],P1[0],P1[1],   pw1[2]=PKW(P0,12),pw1[3]=PKW(P0,14), pw1); \
    VRD(2); SBAR(); GAPA(C0=__builtin_amdgcn_mfma_f32_32x32x16_bf16(kf[4],qr[2],C0,0,0,0),   P1[2],P1[3],P1[4],P1[5],     pw2[0]=PKW(P1,0), pw2[1]=PKW(P1,2), pw2); \
    VRD(6); SBAR(); GAPA(C1=__builtin_amdgcn_mfma_f32_32x32x16_bf16(kf[5],qr[2],C1,0,0,0),   P1[6],P1[7],P1[8],P1[9],     pw2[2]=PKW(P1,4), pw2[3]=PKW(P1,6), pw2); \
    VRD(3); SBAR(); GAPA(C0=__builtin_amdgcn_mfma_f32_32x32x16_bf16(kf[6],qr[3],C0,0,0,0),   P1[10],P1[11],P1[12],P1[13], pw3[0]=PKW(P1,8), pw3[1]=PKW(P1,10), pw3); \
    VRD(7); SBAR(); GAPA(C1=__builtin_amdgcn_mfma_f32_32x32x16_bf16(kf[7],qr[3],C1,0,0,0),   P1[14],P1[15],0.f,0.f,       pw3[2]=PKW(P1,12),pw3[3]=PKW(P1,14), pw3); \
    l_reg+=sacc; \
    if(GK){DMA_K((t)+3,sl_cur);} if(GV){DMA_V((t)+1,sl_next);} \
    CMASK(C0,C1,t); \
    { float a=MX3(C0[0],C0[1],C1[0]),b=MX3(C0[2],C0[3],C1[1]); a=MX3(a,C1[2],C1[3]); \
      _Pragma("unroll") for(int r=4;r<16;r+=4){a=MX3(a,C0[r],C0[r+1]);b=MX3(b,C0[r+2],C0[r+3]);a=MX3(a,C1[r],C1[r+1]);b=MX3(b,C1[r+2],C1[r+3]);} \
      float rm=__builtin_fmaxf(a,b); { auto rr=__builtin_amdgcn_permlane32_swap(__float_as_uint(rm),__float_as_uint(rm),false,false); rm=__builtin_fmaxf(__uint_as_float(rr[0]),__uint_as_float(rr[1])); } \
      resc=false; \
      if(__builtin_expect(__any(rm>(float)THRL),0)){ const float dl=__builtin_fmaxf(rm,0.f); mhat+=dl; \
        _Pragma("unroll") for(int r=0;r<16;++r){C0[r]-=dl;C1[r]-=dl;} \
        dmq=cq-mhat; \
        const float f=__builtin_amdgcn_exp2f(-dl); l_reg*=f; if(hi==0)wsf[r32]=f; resc=true; } } \
    if(GL){ PREP_LD(P0,P1,(t)+1); } SBAR(); \
    GAPB(o[0]=__builtin_amdgcn_mfma_f32_32x32x16_bf16(PAF(0),VFR(0),o[0],0,0,0), C0,0); \
    GAPB(o[1]=__builtin_amdgcn_mfma_f32_32x32x16_bf16(PAF(0),VFR(4),o[1],0,0,0), C0,4); \
    KRD(GL,0); GAPB(o[0]=__builtin_amdgcn_mfma_f32_32x32x16_bf16(PAF(1),VFR(1),o[0],0,0,0), C0,8); \
    KRD(GL,1); GAPB(o[1]=__builtin_amdgcn_mfma_f32_32x32x16_bf16(PAF(1),VFR(5),o[1],0,0,0), C0,12); \
    KRD(GL,2); GAPB(o[0]=__builtin_amdgcn_mfma_f32_32x32x16_bf16(PAF(2),VFR(2),o[0],0,0,0), C1,0); \
    KRD(GL,3); GAPB(o[1]=__builtin_amdgcn_mfma_f32_32x32x16_bf16(PAF(2),VFR(6),o[1],0,0,0), C1,4); \
    GAPB(o[0]=__builtin_amdgcn_mfma_f32_32x32x16_bf16(PAF(3),VFR(3),o[0],0,0,0), C1,8); \
    GAPB(o[1]=__builtin_amdgcn_mfma_f32_32x32x16_bf16(PAF(3),VFR(7),o[1],0,0,0), C1,12); \
    if(GL){ PREP_SUB(P0,P1); } \
    }while(0)
  int t=1;
  #undef CMASK
  #define CMASK(P0,P1,t) do{}while(0)
  for(;t+5<NT;t+=2){
    STEP(pB0,pB1,pA0,pA1,t,true,true,true);     WAIT_BAR(2); RESC(); ROT();
    STEP(pA0,pA1,pB0,pB1,t+1,true,true,true);   WAIT_BAR(2); RESC(); ROT();
  }
  #undef CMASK
  #define CMASK(P0,P1,t) do{int jb_=(t)-(NT-4); if(jb_>=0)cmask(P0,P1,jb_,qrel,hi);}while(0)
  #define ENDW(tt) do{ if((tt)+3<NT){WAIT_BAR(2);} else if((tt)+2<NT){WAIT_BAR(1);} else {WAIT_BAR(0);} }while(0)
  for(;t+1<NT;t+=2){
    STEP(pB0,pB1,pA0,pA1,t,(t+3<NT),(t+1<NT),(t+1<NT));       ENDW(t);   RESC(); ROT();
    STEP(pA0,pA1,pB0,pB1,t+1,(t+4<NT),(t+2<NT),(t+2<NT));     ENDW(t+1); RESC(); ROT();
  }
  STEP(pB0,pB1,pA0,pA1,NT-1,false,false,false); RESC();
  { float sacc=pB0[0]+pB0[1]; _Pragma("unroll") for(int r=2;r<16;++r)sacc+=pB0[r]; _Pragma("unroll") for(int r=0;r<16;++r)sacc+=pB1[r]; l_reg+=sacc;
    pw0=(u32x4){PKW(pB0,0),PKW(pB0,2),PKW(pB0,4),PKW(pB0,6)};pw1=(u32x4){PKW(pB0,8),PKW(pB0,10),PKW(pB0,12),PKW(pB0,14)};pw2=(u32x4){PKW(pB1,0),PKW(pB1,2),PKW(pB1,4),PKW(pB1,6)};pw3=(u32x4){PKW(pB1,8),PKW(pB1,10),PKW(pB1,12),PKW(pB1,14)};
    SBAR(); pv(o,vb0+sl_cur,PAF(0),PAF(1),PAF(2),PAF(3)); }
  #undef PKW
  #undef PAF
  #undef VFR
  #undef PIN
  #undef MX3
  #undef GAPA
  #undef GAPB
  #undef EX
  #undef VRD
  #undef KRD
  #undef STEP
  #undef ENDW
  {auto rr=__builtin_amdgcn_permlane32_swap(__float_as_uint(l_reg),__float_as_uint(l_reg),false,false);l_reg=__uint_as_float(rr[0])+__uint_as_float(rr[1]);}
  if(hi==0)wsf[32+r32]=l_reg;asm volatile("s_waitcnt lgkmcnt(0)":::"memory");
  float rli[16];
  #pragma unroll
  for(int r=0;r<16;++r)rli[r]=__builtin_amdgcn_rcpf(wsf[32+crow(r,hi)]);
  bf16*Ow=O+(rowbase+q0+wid*QBLK)*DMO+h*D; float*sq=ssq+rowbase+q0+wid*QBLK;
  { bf16*stg=(bf16*)(shm+LDS_OST)+wid*2048;
    #pragma unroll
    for(int r=0;r<16;++r){const int orow=crow(r,hi);
      #pragma unroll
      for(int d0=0;d0<2;++d0)stg[orow*64+d0*32+r32]=__float2bfloat16(o[d0][r]*rli[r]);}
    asm volatile("s_waitcnt lgkmcnt(0)":::"memory");
    #pragma unroll
    for(int i=0;i<4;++i){const int row=i*8+(lane>>3),ch=lane&7; const u32x4 v=*(const u32x4*)(stg+row*64+ch*8); ATTN_STORE16(Ow+(long)row*DMO+ch*8,v);
      float q2=0.f; _Pragma("unroll") for(int e=0;e<4;++e){ const float lo_=__uint_as_float(v[e]<<16), hi_=__uint_as_float(v[e]&0xffff0000u); q2+=lo_*lo_+hi_*hi_; }
      q2+=__shfl_xor(q2,1); q2+=__shfl_xor(q2,2); q2+=__shfl_xor(q2,4); if(ch==0)unsafeAtomicAdd(sq+row,q2);} }
  asm volatile("s_waitcnt lgkmcnt(0)\n\ts_barrier":::"memory");
  #undef DMA_K
  #undef DMA_V
  #undef cq
  #undef CMASK
  #undef PREP_LD
  #undef PREP_SUB
  #undef START
  #undef RESC
  #undef ROT
}
constexpr int ATTN_LDS_BYTES=LDS_BYTES;
__device__ __forceinline__ void swa_unit(int b,int kvh,int qblk,const bf16*Q,const bf16*__restrict__ K,const bf16*__restrict__ V,bf16*O,const float*sinks,float*ssq,char*shm,const int MKW){
  const int lane=mk_lane(),r32=lane&31,hi=lane>>5; const int wid=MKW;
  const long rowbase=(long)b*SEQ; const int q0=qblk*64, jh=wid&1, hq=kvh*4+(wid>>1);
  const bf16*Qw=Q+(rowbase+q0+32*jh)*DMQ+hq*D;
  const bf16*Kh=K+rowbase*DMQ+kvh*D,*Vh=V+rowbase*DMQ+kvh*D;
  const unsigned lds0=(unsigned)(uintptr_t)shm;
  float*wsf=(float*)(shm+LDS_WS)+wid*64;
  const bf16*ksrc=Kh+(long)lane*DMQ+wid*8;
  const bf16*vsrc=Vh+(long)(16*(wid&3)+(lane>>2))*DMQ+(wid>>2)*32+(lane&3)*8;
  const unsigned kdst=lds0+LDS_K+wid*1024, vdst=lds0+LDS_V+wid*1024;
  const int vb0=(int)(lds0+LDS_V)+((lane>>4)&1)*32+(lane&3)*8+(4*hi+((lane&15)>>2))*64;
  const char*Kbase=shm+LDS_K;
  const int nt=qblk>=2?3:qblk+1;
  #pragma unroll
  for(int i=0;i<3;++i){ if(i<nt){ const int tile=(i==0)?(qblk>=1?qblk-1:qblk):(i==1?qblk:qblk-2);
      glds16(ksrc+(long)tile*KVBLK*DMQ,(unsigned)__builtin_amdgcn_readfirstlane(kdst+i*SLOTB)); glds16(vsrc+(long)tile*KVBLK*DMQ,(unsigned)__builtin_amdgcn_readfirstlane(vdst+i*SLOTB)); } }
  bf16x8 qr[4];
  #pragma unroll
  for(int d0=0;d0<4;++d0)qr[d0]=*reinterpret_cast<const bf16x8*>(&Qw[(long)r32*DMQ+d0*16+hi*8]);
  float mhat=0.f,l_reg=0.f;f32x16 o[2];o[0]=f32x16{};o[1]=f32x16{};f32x16 negm=f32x16{};
  const int tq=q0+32*jh+r32;
  WAIT_BAR(0);
  #pragma unroll
  for(int i=0;i<3;++i){ if(i<nt){ const int tile=(i==0)?(qblk>=1?qblk-1:qblk):(i==1?qblk:qblk-2);
    f32x16 p0,p1;
    qkt(p0,p1,Kbase+i*SLOTB,qr,negm,negm,r32,hi); asm volatile("s_nop 15\n\ts_nop 7":"+v"(p0),"+v"(p1));
    { const int kb=tile*64+4*hi;
      #pragma unroll
      for(int r=0;r<16;++r){ const int dd=tq-(kb+(r&3)+8*(r>>2)); if(dd<0||dd>=128)p0[r]=-INFINITY; if(dd-32<0||dd-32>=128)p1[r]=-INFINITY; } }
    const float rm=rowmax(p0,p1);
    if(i==0){ mhat=rm;
      #pragma unroll
      for(int r=0;r<16;++r){p0[r]-=rm;p1[r]-=rm;} }
    else { const float dl=fmaxf(rm,0.f);
      if(__any(dl>0.f)){ mhat+=dl;
        #pragma unroll
        for(int r=0;r<16;++r){p0[r]-=dl;p1[r]-=dl;}
        const float f=__builtin_amdgcn_exp2f(-dl); l_reg*=f; if(hi==0)wsf[r32]=f; asm volatile("s_waitcnt lgkmcnt(0)":::"memory");
        #pragma unroll
        for(int d_=0;d_<2;++d_){
          #pragma unroll
          for(int r=0;r<16;++r)o[d_][r]*=wsf[crow(r,hi)]; }
        asm volatile("s_waitcnt lgkmcnt(0)":::"memory"); } }
    #pragma unroll
    for(int r=0;r<16;++r)negm[r]=-mhat;
    float sacc=0.f;
    #pragma unroll
    for(int r=0;r<16;++r){p0[r]=__builtin_amdgcn_exp2f(p0[r]);p1[r]=__builtin_amdgcn_exp2f(p1[r]);sacc+=p0[r]+p1[r];}
    l_reg+=sacc;
    u32x4 pw0,pw1,pw2,pw3;
    pw0=(u32x4){cvtpk_s(p0[0],p0[1]),cvtpk_s(p0[2],p0[3]),cvtpk_s(p0[4],p0[5]),cvtpk_s(p0[6],p0[7])};
    pw1=(u32x4){cvtpk_s(p0[8],p0[9]),cvtpk_s(p0[10],p0[11]),cvtpk_s(p0[12],p0[13]),cvtpk_s(p0[14],p0[15])};
    pw2=(u32x4){cvtpk_s(p1[0],p1[1]),cvtpk_s(p1[2],p1[3]),cvtpk_s(p1[4],p1[5]),cvtpk_s(p1[6],p1[7])};
    pw3=(u32x4){cvtpk_s(p1[8],p1[9]),cvtpk_s(p1[10],p1[11]),cvtpk_s(p1[12],p1[13]),cvtpk_s(p1[14],p1[15])};
    SBAR(); pv(o,vb0+i*SLOTB,__builtin_bit_cast(bf16x8,pw0),__builtin_bit_cast(bf16x8,pw1),__builtin_bit_cast(bf16x8,pw2),__builtin_bit_cast(bf16x8,pw3)); } }
  {auto rr=__builtin_amdgcn_permlane32_swap(__float_as_uint(l_reg),__float_as_uint(l_reg),false,false);l_reg=__uint_as_float(rr[0])+__uint_as_float(rr[1]);}
  l_reg+=__builtin_amdgcn_exp2f(sinks[hq]*1.4426950408889634f-mhat);
  if(hi==0)wsf[32+r32]=l_reg;asm volatile("s_waitcnt lgkmcnt(0)":::"memory");
  float rli[16];
  #pragma unroll
  for(int r=0;r<16;++r)rli[r]=__builtin_amdgcn_rcpf(wsf[32+crow(r,hi)]);
  bf16*Ow=O+(rowbase+q0+32*jh)*DMO+hq*D; float*sq=ssq+rowbase+q0+32*jh;
  { bf16*stg=(bf16*)(shm+LDS_OST)+wid*2048;
    #pragma unroll
    for(int r=0;r<16;++r){const int orow=crow(r,hi);
      #pragma unroll
      for(int d0=0;d0<2;++d0)stg[orow*64+d0*32+r32]=__float2bfloat16(o[d0][r]*rli[r]);}
    asm volatile("s_waitcnt lgkmcnt(0)":::"memory");
    #pragma unroll
    for(int i=0;i<4;++i){const int row=i*8+(lane>>3),ch=lane&7; const u32x4 v=*(const u32x4*)(stg+row*64+ch*8); ATTN_STORE16(Ow+(long)row*DMO+ch*8,v);
      float q2=0.f; _Pragma("unroll") for(int e=0;e<4;++e){ const float lo_=__uint_as_float(v[e]<<16), hi_=__uint_as_float(v[e]&0xffff0000u); q2+=lo_*lo_+hi_*hi_; }
      q2+=__shfl_xor(q2,1); q2+=__shfl_xor(q2,2); q2+=__shfl_xor(q2,4); if(ch==0)unsafeAtomicAdd(sq+row,q2);} }
  asm volatile("s_waitcnt lgkmcnt(0)\n\ts_barrier":::"memory");
}
struct AttnArgs { const bf16* proj; bf16* att; const float* c; const float* sinks; float* ssqA; float* ssqB; };
template<int THRL=8> __device__ __forceinline__ void attn_phase(char*lds,const AttnArgs&A,int vcu,int G,const int MKW){
  const int tid=MKW*64+mk_lane();
  for(int u=vcu;u<BATCH*2*(SEQ/64);u+=G){ const int qblk=u%(SEQ/64), bk=u/(SEQ/64); swa_unit(bk>>1,bk&1,qblk,A.proj+0,A.proj+512,A.proj+640,A.att,A.sinks,A.ssqA,lds,MKW); }
  if(vcu<BATCH*NHEAD*16){ const int bh=vcu>>4, s=vcu&15;
    __attribute__((address_space(3))) float* cl=(__attribute__((address_space(3))) float*)((__attribute__((address_space(3))) char*)(uintptr_t)(unsigned)(uintptr_t)lds+86016);
    { const float* cg=A.c+(long)bh*SEQ;
      for(int i=tid;i<SEQ/4;i+=NW*64){ f32x4_t v=((const f32x4_t*)cg)[i]; v=v*1.4426950408889634f; ((__attribute__((address_space(3))) f32x4_t*)cl)[i]=v; } }
    asm volatile("s_waitcnt vmcnt(0) lgkmcnt(0)\n\ts_barrier":::"memory");
    #pragma unroll 1
    for(int i=0;i<2;++i){ const int qb=(i==0)?s:31-s; attn_unit<THRL>(bh>>3,bh&7,qb,A.proj+768,A.proj+1280,A.proj+1792,A.att+512,lds,(lds_fptr)cl,A.ssqB,MKW); } }
}
#undef SBAR
#undef WAIT_BAR
}
constexpr int BATCH = 2, SEQ = 8192, D = 1024, M = BATCH * SEQ;
constexpr int INW = 2312, NPROJ = 2304;
constexpr int PC_QA = 0, PC_KA = 512, PC_VA = 640, PC_QF = 768, PC_KF = 1280, PC_VF = 1792;
constexpr int NEXP = 16384, PLE_DIM = 256, NSC = 2048;
constexpr float RMS_EPS = 1e-6f;
constexpr size_t MiB = 1u << 20, KiB = 1024;
constexpr size_t WS_CTL = 0, CTL_ZERO_BYTES = 512 * KiB;
constexpr size_t WS_SSQ = 64 * KiB;
constexpr size_t WS_C = 512 * KiB;
constexpr size_t WS_WIN = 1 * MiB, WS_WOUT = WS_WIN + 4608 * KiB, WS_WEFF = WS_WOUT + 2 * MiB, WS_WPG = WS_WEFF + 4 * MiB, WS_WPP = WS_WPG + 2 * MiB;
constexpr size_t WS_ROPE = 14 * MiB;
constexpr size_t WS_PB = 16 * MiB;
constexpr size_t WS_U = 24 * MiB, WS_V = 56 * MiB;
constexpr size_t WS_XN = 88 * MiB;
constexpr size_t WS_PROJ = 120 * MiB;
constexpr size_t WS_H2B = 88 * MiB, WS_IDX = 152 * MiB, WS_GATE = 156 * MiB;
constexpr size_t WS_PD0 = 120 * MiB, WS_PD1 = 192 * MiB, WS_COEF = 164 * MiB;
constexpr size_t WS_ATT = 192 * MiB;
constexpr size_t WS_PLE = 224 * MiB;
constexpr size_t WS_END = 256 * MiB;
static_assert(WS_WPP + 512 * KiB <= WS_ROPE && WS_PROJ + (size_t)M * NPROJ * 2 <= WS_ATT && WS_PLE + (size_t)M * D * 2 <= WS_END, "d_ws map");
constexpr int CW_TMO = 0, CW_CODE = 1, CW_BAR = 4096, CW_Q = 8192;
constexpr int RING_OFF = 0, RING_BYTES = 131072;
constexpr int LDSCTL_OFF = 135168, MISC_OFF = LDSCTL_OFF + 320, TAB_OFF = LDSCTL_OFF + 512, PTAB_OFF = LDSCTL_OFF + 2560;
constexpr int LDS_BYTES = 147456;
constexpr int NWAVES = 8;
#define GAS __attribute__((address_space(1)))
#define LAS __attribute__((address_space(3)))
typedef unsigned short bf16;
typedef unsigned v4u __attribute__((ext_vector_type(4)));
typedef float f32x4 __attribute__((ext_vector_type(4)));
typedef short bf16x8 __attribute__((ext_vector_type(8)));
typedef GAS unsigned gu32;
typedef GAS unsigned long long gu64;
#define RLX_AGENT __ATOMIC_RELAXED, __HIP_MEMORY_SCOPE_AGENT
#define LDS_WAIT() asm volatile("s_waitcnt lgkmcnt(0)" ::: "memory")
#define VM_WAIT() asm volatile("s_waitcnt vmcnt(0)" ::: "memory")
__device__ __forceinline__ unsigned long long rt() { return __builtin_amdgcn_s_memrealtime(); }
__device__ __forceinline__ unsigned f2bf(float f) { unsigned u = __builtin_bit_cast(unsigned, f); return (u + 0x7fffu + ((u >> 16) & 1u)) >> 16; }
__device__ __forceinline__ unsigned pk2(float lo, float hi) { return f2bf(lo) | (f2bf(hi) << 16); }

#define XB_TMO      128
#define XB_XCNT(j)  (256  + 64 * (j))
#define XB_XSUB(j)  (1280 + 64 * (j))
#define XB_XGEN(j)  (2304 + 64 * (j))
#define XB_TOP      3328
#define XB_TOPGEN   3392
#define XCD_BAR_WORDS 3456
#define XB_SPIN_CAP (1u << 18)

__device__ __forceinline__ unsigned xb_ld(unsigned* p)              { return __hip_atomic_load(p, __ATOMIC_RELAXED, __HIP_MEMORY_SCOPE_AGENT); }
__device__ __forceinline__ unsigned xb_add(unsigned* p, unsigned v) { return __hip_atomic_fetch_add(p, v, __ATOMIC_RELAXED, __HIP_MEMORY_SCOPE_AGENT); }
__device__ __forceinline__ unsigned xb_xcc_id() { return (unsigned)__builtin_amdgcn_s_getreg((3 << 11) | 20) & 0xFu; }
#define XB_SPIN(cond, bar) do { unsigned _sp = 0; while (cond) { __builtin_amdgcn_s_sleep(1); \
    if ((++_sp & 255u) == 0u) { if (xb_ld(&(bar)[XB_TMO])) break; if (_sp > XB_SPIN_CAP) { atomicAdd(&(bar)[XB_TMO], 1u); break; } } } } while (0)

struct XcdBarrier {
    unsigned* bar; unsigned x;
    volatile LAS unsigned* st;
};

__device__ __forceinline__ XcdBarrier xcd_barrier_post(unsigned* bar, volatile LAS unsigned* st, const int MKW) {
    XcdBarrier b; b.bar = bar; b.x = xb_xcc_id(); b.st = st;
    if (MKW == 0 && mk_lane() == 0) (void)xb_add(&bar[XB_XCNT(b.x)], 1u);
    return b;
}
__device__ __forceinline__ void xcd_barrier_complete(unsigned* bar, unsigned x, unsigned& nloc, unsigned& nx) {
    const unsigned G = gridDim.x * gridDim.y * gridDim.z;
    unsigned sum, cnt, mine, sp = 0u;
    for (;;) {
        sum = 0u; cnt = 0u; mine = 0u;
#pragma unroll
        for (unsigned j = 0; j < 16; ++j) { const unsigned c = xb_ld(&bar[XB_XCNT(j)]); sum += c; cnt += (c > 0u) ? 1u : 0u; mine = (j == x) ? c : mine; }
        if (sum == G) break;
        __builtin_amdgcn_s_sleep(1);
        if ((++sp & 255u) == 0u) { if (xb_ld(&bar[XB_TMO])) break; if (sp > XB_SPIN_CAP) { atomicAdd(&bar[XB_TMO], 1u); break; } }
    }
    nloc = mine > 0u ? mine : 1u; nx = cnt > 0u ? cnt : 1u;
}

__device__ __forceinline__ void xcd_barrier(const XcdBarrier& b, const int MKW) {
    asm volatile("s_waitcnt vmcnt(0)" ::: "memory");
    __syncthreads();
    if (MKW == 0 && mk_lane() == 0) {
        unsigned* bar = b.bar;
        __builtin_amdgcn_s_waitcnt(0);
        unsigned nloc = b.st[0], nx = b.st[1];
        if (nloc == 0u) { xcd_barrier_complete(bar, b.x, nloc, nx); b.st[0] = nloc; b.st[1] = nx; }
        const unsigned old = xb_add(&bar[XB_XSUB(b.x)], 1u);
        const unsigned gen = old / nloc;
        if (old + 1u == (gen + 1u) * nloc) {
            __builtin_amdgcn_fence(__ATOMIC_RELEASE, "agent");
            asm volatile("s_waitcnt vmcnt(0)" ::: "memory");
            const unsigned og = xb_add(&bar[XB_TOP], 1u);
            const unsigned tg = og / nx;
            if (og + 1u == (tg + 1u) * nx) xb_add(&bar[XB_TOPGEN], 1u);
            else XB_SPIN(xb_ld(&bar[XB_TOPGEN]) == tg, bar);
            __builtin_amdgcn_fence(__ATOMIC_ACQUIRE, "agent");
            xb_add(&bar[XB_XGEN(b.x)], 1u);
            asm volatile("s_waitcnt vmcnt(0)" ::: "memory");
        } else {
            XB_SPIN(xb_ld(&bar[XB_XGEN(b.x)]) == gen, bar);
            __builtin_amdgcn_fence(__ATOMIC_ACQUIRE, "agent");
            asm volatile("s_waitcnt vmcnt(0)" ::: "memory");
        }
    }
    __syncthreads();
}
typedef float f32x2g __attribute__((ext_vector_type(2)));
struct Frame {
    LAS unsigned char* lds;
    volatile LAS unsigned* MISC;
    gu32* ctl;
    int wave;
    int vcu, G;
    float* out; unsigned char* ws;
};
enum { I_X = 0, I_P, I_GMIX, I_WIN, I_BF, I_SINKS, I_GA, I_GB, I_WOUT, I_GFFN, I_WQ, I_SK, I_EU, I_EV, I_GPLE, I_WPG, I_WPP, I_GFIN };
__device__ __forceinline__ const float* inptr(const Frame& F, int i) {
    const unsigned long long v = ((volatile LAS unsigned long long*)(F.lds + PTAB_OFF))[i];
    const unsigned lo = (unsigned)__builtin_amdgcn_readfirstlane((int)(unsigned)v), hi = (unsigned)__builtin_amdgcn_readfirstlane((int)(unsigned)(v >> 32));
    return (const float*)(((unsigned long long)hi << 32) | lo);
}
#define mk_tid() (F.wave * 64 + mk_lane())
__device__ __forceinline__ float wave_sum(float v) {
#pragma unroll
    for (int o = 1; o < 64; o <<= 1) v += __shfl_xor(v, o);
    return v;
}
__device__ __forceinline__ void p0_transpose_item(const float* W, int ldw, int K, int nblk, const float* gain, int rope_lim, bf16* WT, LAS float* scr, int item, int lane) {
    const int kb = item / nblk, nb = item % nblk, k0 = 64 * kb, n0 = 32 * nb;
#pragma unroll 8
    for (int i = 0; i < 32; ++i) { const int kk = 2 * i + (lane >> 5); float v = W[(size_t)(k0 + kk) * ldw + n0 + (lane & 31)]; if (gain) v *= gain[k0 + kk]; scr[kk * 33 + (lane & 31)] = v; }
    LDS_WAIT(); asm volatile("" ::: "memory");
    const int c = lane & 7;
#pragma unroll
    for (int j = 0; j < 4; ++j) { const int n = (lane >> 3) + 8 * j; const LAS float* s = scr + (8 * c) * 33 + n;
        v4u o; o.x = pk2(s[0 * 33], s[1 * 33]); o.y = pk2(s[2 * 33], s[3 * 33]); o.z = pk2(s[4 * 33], s[5 * 33]); o.w = pk2(s[6 * 33], s[7 * 33]);
        int nn = n0 + n; if (nn < rope_lim) { const int pp = nn & 63; nn = (nn & ~63) + (pp < 32 ? 2 * pp : 2 * (pp - 32) + 1); }
        *(GAS v4u*)(WT + (size_t)nn * K + k0 + 8 * c) = o; }
    LDS_WAIT(); asm volatile("" ::: "memory");
}
__device__ __forceinline__ void p0_weff_item(const float* wq, const float* sk, const float* gain, bf16* WT, LAS float* scr, int item, int lane) {
    const int kb = item >> 6, nb = item & 63, k0 = 32 * kb, n0 = 32 * nb, hc = n0 >> 7, c = hc & 1, key = (n0 & 127) + (lane & 31);
    const f32x4* skr = (const f32x4*)(sk + ((size_t)c * 128 + key) * 128);
    float acc[16];
#pragma unroll
    for (int i = 0; i < 16; ++i) acc[i] = 0.f;
    for (int d4 = 0; d4 < 32; ++d4) { const f32x4 s = skr[d4];
#pragma unroll
        for (int i = 0; i < 16; ++i) { const int kk = 2 * i + (lane >> 5); const f32x4 w = *(const f32x4*)(wq + (size_t)(k0 + kk) * 2048 + hc * 128 + d4 * 4);
            acc[i] += (w[0] * s[0] + w[1] * s[1]) + (w[2] * s[2] + w[3] * s[3]); } }
#pragma unroll
    for (int i = 0; i < 16; ++i) { const int kk = 2 * i + (lane >> 5); scr[kk * 33 + (lane & 31)] = acc[i] * gain[k0 + kk]; }
    LDS_WAIT(); asm volatile("" ::: "memory");
#pragma unroll
    for (int j = 0; j < 2; ++j) { const int piece = lane + 64 * j, n = piece >> 2, ch = piece & 3; const LAS float* s = scr + (8 * ch) * 33 + n;
        v4u o; o.x = pk2(s[0 * 33], s[1 * 33]); o.y = pk2(s[2 * 33], s[3 * 33]); o.z = pk2(s[4 * 33], s[5 * 33]); o.w = pk2(s[6 * 33], s[7 * 33]);
        *(GAS v4u*)(WT + (size_t)(n0 + n) * 1024 + k0 + 8 * ch) = o; }
    LDS_WAIT(); asm volatile("" ::: "memory");
}
__device__ __forceinline__ void p0_xn_row(Frame& F, int lane, int m, const LAS float* GL, const float* x, const float* g_mix, const float* b_forget) {
    const GAS f32x4* xr = (const GAS f32x4*)(x + (size_t)m * D) + lane; const f32x4* gr = (const f32x4*)g_mix + lane;
    f32x4 v[4]; float s = 0.f;
#pragma unroll
    for (int j = 0; j < 4; ++j) { v[j] = xr[64 * j]; s += (v[j].x * v[j].x + v[j].y * v[j].y) + (v[j].z * v[j].z + v[j].w * v[j].w); }
    const float rstd = 1.0f / sqrtf(wave_sum(s) * (1.f / D) + RMS_EPS);
#pragma unroll
    for (int j = 0; j < 4; ++j) v[j] = v[j] * rstd * gr[64 * j];
    bf16* orow = (bf16*)(F.ws + WS_XN) + (size_t)m * D;
    GAS unsigned long long* o8 = (GAS unsigned long long*)orow + lane;
#pragma unroll
    for (int j = 0; j < 4; ++j) o8[64 * j] = (unsigned long long)pk2(v[j].x, v[j].y) | ((unsigned long long)pk2(v[j].z, v[j].w) << 32);
    float z[8];
#pragma unroll
    for (int h = 0; h < 8; ++h) { float a = 0.f;
#pragma unroll
        for (int j = 0; j < 4; ++j) { const f32x4 g = *(const LAS f32x4*)(GL + h * 1024 + 4 * lane + 256 * j); a += (v[j].x * g[0] + v[j].y * g[1]) + (v[j].z * g[2] + v[j].w * g[3]); }
        z[h] = wave_sum(a); }
    if (lane < 8) { float zz = z[0];
#pragma unroll
        for (int h = 1; h < 8; ++h) zz = (lane == h) ? z[h] : zz;
        zz += b_forget[lane];
        const float lf = fminf(zz, 0.f) - log1pf(expf(-fabsf(zz)));
        const int b = m / SEQ, sidx = m % SEQ;
        ((float*)(F.ws + WS_C))[((size_t)b * 8 + lane) * SEQ + sidx] = lf; }
}
__device__ __forceinline__ void p0_prologue(Frame& F) {
    const int tid = mk_tid(), lane = tid & 63;
    const float *x = inptr(F, I_X), *pp = inptr(F, I_P), *g_mix = inptr(F, I_GMIX), *w_in = inptr(F, I_WIN), *b_forget = inptr(F, I_BF), *g_out_a = inptr(F, I_GA), *g_out_b = inptr(F, I_GB), *w_out = inptr(F, I_WOUT),
                *g_ffn = inptr(F, I_GFFN), *w_query = inptr(F, I_WQ), *sub_keys = inptr(F, I_SK), *expert_u = inptr(F, I_EU), *expert_v = inptr(F, I_EV), *g_ple = inptr(F, I_GPLE), *w_ple_gate = inptr(F, I_WPG), *w_ple_proj = inptr(F, I_WPP);
    LAS float* GL = (LAS float*)(F.lds + RING_OFF + 73728);
    for (int col = tid; col < D; col += NWAVES * 64) { const f32x4 a = *(const f32x4*)(w_in + (size_t)col * INW + NPROJ), b = *(const f32x4*)(w_in + (size_t)col * INW + NPROJ + 4);
        GL[0 * 1024 + col] = a[0]; GL[1 * 1024 + col] = a[1]; GL[2 * 1024 + col] = a[2]; GL[3 * 1024 + col] = a[3]; GL[4 * 1024 + col] = b[0]; GL[5 * 1024 + col] = b[1]; GL[6 * 1024 + col] = b[2]; GL[7 * 1024 + col] = b[3]; }
    __syncthreads();
    LAS float* scr = (LAS float*)(F.lds + RING_OFF + F.wave * 9216);
    const int gw = F.vcu * NWAVES + F.wave, NGW = F.G * NWAVES;
    for (int it = gw; it < 2048; it += NGW) p0_weff_item(w_query, sub_keys, g_ffn, (bf16*)(F.ws + WS_WEFF), scr, it, lane);
    constexpr int I_IN = 16 * 72, I_OUT = 16 * 32, I_PG = 16 * 32, I_PP = 4 * 32;
    for (int it = gw; it < I_IN + I_OUT + I_PG + I_PP; it += NGW) { int r = it;
        if (r < I_IN) { p0_transpose_item(w_in, INW, D, 72, nullptr, 640, (bf16*)(F.ws + WS_WIN), scr, r, lane); continue; } r -= I_IN;
        if (r < I_OUT) { const int kb = r / 32; p0_transpose_item(w_out, D, D, 32, kb < 8 ? g_out_a : g_out_b - 512, 0, (bf16*)(F.ws + WS_WOUT), scr, r, lane); continue; } r -= I_OUT;
        if (r < I_PG) { p0_transpose_item(w_ple_gate, D, D, 32, g_ple, 0, (bf16*)(F.ws + WS_WPG), scr, r, lane); continue; } r -= I_PG;
        p0_transpose_item(w_ple_proj, D, PLE_DIM, 32, nullptr, 0, (bf16*)(F.ws + WS_WPP), scr, r, lane); }
    for (int e = gw * 64 + lane; e < SEQ * 32; e += NGW * 64) { const int pos = e >> 5, i = e & 31; double inv = 1.0;
        for (int q = 0; q < i; ++q) inv *= 0.7498942093324559;
        const double rev = (double)pos * inv * 0.15915494309189535; const float fr = (float)(rev - __builtin_rint(rev));
        ((f32x2g*)(F.ws + WS_ROPE))[e] = (f32x2g){__builtin_amdgcn_cosf(fr), __builtin_amdgcn_sinf(fr)}; }
    for (int m = gw; m < M; m += NGW) p0_xn_row(F, lane, m, GL, x, g_mix, b_forget);
    for (int m = gw; m < M; m += NGW) { const f32x4 v = *((const GAS f32x4*)(pp + (size_t)m * PLE_DIM) + lane);
        *((GAS unsigned long long*)((bf16*)(F.ws + WS_PB) + (size_t)m * PLE_DIM) + lane) = (unsigned long long)pk2(v.x, v.y) | ((unsigned long long)pk2(v.z, v.w) << 32); }
    for (int r = gw; r < 2 * NEXP; r += NGW) { const int tb = r >> 14, e = r & (NEXP - 1); const GAS f32x4* src = (const GAS f32x4*)((tb ? expert_v : expert_u) + (size_t)e * D) + lane;
        bf16* dstb = (bf16*)(F.ws + (tb ? WS_V : WS_U)); const f32x4* gr = (const f32x4*)g_ffn + lane;
#pragma unroll
        for (int j = 0; j < 4; ++j) { f32x4 v = src[64 * j]; if (!tb) v = v * gr[64 * j]; const int col = 4 * lane + 256 * j;
            *(GAS unsigned long long*)(dstb + ((size_t)(col >> 6) * NEXP + e) * 64 + (col & 63)) = (unsigned long long)pk2(v.x, v.y) | ((unsigned long long)pk2(v.z, v.w) << 32); } }
}
__device__ __forceinline__ void p1_cumsum(Frame& F, int bh) {
    const int tid = mk_tid(), lane = tid & 63;
    float* c = (float*)(F.ws + WS_C) + (size_t)bh * SEQ + tid * 16; LAS float* sc = (LAS float*)(F.lds + RING_OFF);
    f32x4 v[4];
#pragma unroll
    for (int j = 0; j < 4; ++j) v[j] = ((const f32x4*)c)[j];
    float run = 0.f;
#pragma unroll
    for (int j = 0; j < 4; ++j) { v[j].x += run; v[j].y += v[j].x; v[j].z += v[j].y; v[j].w += v[j].z; run = v[j].w; }
    float inc = run;
#pragma unroll
    for (int o = 1; o < 64; o <<= 1) { const float t = __shfl_up(inc, o); if (lane >= o) inc += t; }
    if (lane == 63) sc[F.wave] = inc;
    __syncthreads();
    float base = inc - run;
    for (int w = 0; w < F.wave; ++w) base += sc[w];
#pragma unroll
    for (int j = 0; j < 4; ++j) { v[j] = v[j] + base; ((f32x4*)c)[j] = v[j]; }
    __syncthreads();
}
typedef __bf16 bf16x2_t __attribute__((ext_vector_type(2)));
__device__ __forceinline__ float dot2bf(unsigned a, unsigned b, float c) { return __builtin_amdgcn_fdot2_f32_bf16(__builtin_bit_cast(bf16x2_t, a), __builtin_bit_cast(bf16x2_t, b), c, false); }
__device__ __forceinline__ float dot8bf(const v4u& a, const v4u& b, float c) { c = dot2bf(a.x, b.x, c); c = dot2bf(a.y, b.y, c); c = dot2bf(a.z, b.z, c); return dot2bf(a.w, b.w, c); }
__device__ __forceinline__ float swap32_add(float a, float b) {
    auto rr = __builtin_amdgcn_permlane32_swap(__float_as_uint(a), __float_as_uint(b), false, false); return __uint_as_float(rr[0]) + __uint_as_float(rr[1]); }
__device__ __forceinline__ float swap16_add(float a, float b) {
    auto rr = __builtin_amdgcn_permlane16_swap(__float_as_uint(a), __float_as_uint(b), false, false); return __uint_as_float(rr[0]) + __uint_as_float(rr[1]); }
__device__ __forceinline__ float gelu_erf(float v) { return 0.5f * v * (1.0f + erff(v * 0.70710678118654752f)); }
template <int CTRL> __device__ __forceinline__ float dpp_add(float v) { return v + __uint_as_float((unsigned)__builtin_amdgcn_update_dpp(0, (int)__float_as_uint(v), CTRL, 0xf, 0xf, true)); }
__device__ __forceinline__ float octet_sum(float v) { v = dpp_add<0xB1>(v); v = dpp_add<0x4E>(v); return dpp_add<0x141>(v); }
constexpr int NSL = 16;
__device__ __forceinline__ int q_grab(gu32* ctr, int lane) { int v = 0; if (lane == 0) v = (int)__hip_atomic_fetch_add(ctr, 8u, __ATOMIC_RELAXED, __HIP_MEMORY_SCOPE_AGENT); return __builtin_amdgcn_readfirstlane(v); }
__device__ __forceinline__ unsigned idx_at(const v4u& i0, const v4u& i1, int i) { const unsigned w = (i < 8 ? i0 : i1)[(i & 7) >> 1]; return (i & 1) ? (w >> 16) : (w & 0xffffu); }
__device__ __forceinline__ unsigned char* pd_slice(unsigned char* ws, int s) { return ws + (s < 8 ? WS_PD0 + (size_t)s * 4 * MiB : WS_PD1 + (size_t)(s - 8) * 4 * MiB); }
__device__ __forceinline__ void p6a_item(const unsigned char* us, const bf16* H1B, const unsigned short* IDX, bf16* pd, int t, int s, int lane) {
    const int g = lane >> 3, sub = lane & 7;
    const v4u xq = *(const GAS v4u*)(H1B + (size_t)t * D + 64 * s + 8 * sub);
    const v4u i0 = *(const GAS v4u*)(IDX + (size_t)t * 128 + 16 * g), i1 = *(const GAS v4u*)(IDX + (size_t)t * 128 + 16 * g + 8);
    float r0 = 0.f, r1 = 0.f;
#pragma unroll
    for (int i = 0; i < 16; ++i) { const unsigned e = idx_at(i0, i1, i); const v4u row = *(const GAS v4u*)(us + (e * 128u + (unsigned)sub * 16u));
        const float p = octet_sum(dot8bf(xq, row, 0.f));
        if (i < 8) r0 = (sub == i) ? p : r0; else r1 = (sub == i - 8) ? p : r1; }
    pd[(size_t)t * 128 + 16 * g + sub] = (bf16)f2bf(r0); pd[(size_t)t * 128 + 16 * g + 8 + sub] = (bf16)f2bf(r1);
}
__device__ __forceinline__ void p6b_item(const unsigned char* vs, const unsigned* COEF, const unsigned short* IDX, float* h, bf16* H2B, float* ssq2, int t, int s, int lane) {
    const int g = lane >> 3, sub = lane & 7;
    const v4u i0 = *(const GAS v4u*)(IDX + (size_t)t * 128 + 16 * g), i1 = *(const GAS v4u*)(IDX + (size_t)t * 128 + 16 * g + 8);
    v4u c[4];
#pragma unroll
    for (int q = 0; q < 4; ++q) c[q] = *(const GAS v4u*)(COEF + (size_t)t * 128 + 16 * g + 4 * q);
    float y[8];
#pragma unroll
    for (int j = 0; j < 8; ++j) y[j] = 0.f;
#pragma unroll
    for (int i = 0; i < 16; ++i) { const unsigned e = idx_at(i0, i1, i); const v4u row = *(const GAS v4u*)(vs + (e * 128u + (unsigned)sub * 16u)); const unsigned clo = c[i >> 2][i & 3], chi = clo << 16;
        y[0] = dot2bf(row.x, clo, y[0]); y[1] = dot2bf(row.x, chi, y[1]); y[2] = dot2bf(row.y, clo, y[2]); y[3] = dot2bf(row.y, chi, y[3]);
        y[4] = dot2bf(row.z, clo, y[4]); y[5] = dot2bf(row.z, chi, y[5]); y[6] = dot2bf(row.w, clo, y[6]); y[7] = dot2bf(row.w, chi, y[7]); }
#pragma unroll
    for (int j = 0; j < 8; ++j) { float v = dpp_add<0x128>(y[j]); v = swap16_add(v, v); y[j] = swap32_add(v, v); }
    float q2 = 0.f;
    if (g == 0) { GAS f32x4* hp = (GAS f32x4*)(h + (size_t)t * D + 64 * s + 8 * sub); f32x4 a0 = hp[0], a1 = hp[1];
        a0 = a0 + (f32x4){y[0], y[1], y[2], y[3]}; a1 = a1 + (f32x4){y[4], y[5], y[6], y[7]}; hp[0] = a0; hp[1] = a1;
        v4u w; w.x = pk2(a0.x, a0.y); w.y = pk2(a0.z, a0.w); w.z = pk2(a1.x, a1.y); w.w = pk2(a1.z, a1.w); *(GAS v4u*)(H2B + (size_t)t * D + 64 * s + 8 * sub) = w;
        q2 = (a0.x * a0.x + a0.y * a0.y) + (a0.z * a0.z + a0.w * a0.w) + (a1.x * a1.x + a1.y * a1.y) + (a1.z * a1.z + a1.w * a1.w); }
    q2 = octet_sum(q2); if (lane == 0) unsafeAtomicAdd(ssq2 + t, q2);
}
__device__ __forceinline__ int slice_order(int x, int o) { return ((x + (o >> 1)) & 7) + 8 * (o & 1); }
__device__ __forceinline__ void p6a_phase(Frame& F) {
    const int lane = mk_lane(), x = (int)(xb_xcc_id() & 7u); const bf16* const H1B = (const bf16*)(F.ws + WS_XN); const unsigned short* const IDX = (const unsigned short*)(F.ws + WS_IDX);
#pragma unroll 1
    for (int o = 0; o < NSL; ++o) { const int s = slice_order(x, o); gu32* ctr = F.ctl + CW_Q + 64 * s; const unsigned char* us = F.ws + WS_U + (size_t)s * 2 * MiB; bf16* pd = (bf16*)pd_slice(F.ws, s);
        for (;;) { const int t0 = q_grab(ctr, lane); if (t0 >= M) break;
#pragma unroll 1
            for (int t = t0; t < t0 + 8; ++t) p6a_item(us, H1B, IDX, pd, t, s, lane); } }
}
__device__ __forceinline__ void p6c_phase(Frame& F) {
    const int lane = mk_lane(), gw = F.vcu * NWAVES + F.wave, NGW = F.G * NWAVES; const float* const SSQ = (const float*)(F.ws + WS_SSQ); const float* const GATE = (const float*)(F.ws + WS_GATE); unsigned* const COEF = (unsigned*)(F.ws + WS_COEF);
    for (int t = gw; t < M; t += NGW) { float a0 = 0.f, a1 = 0.f;
#pragma unroll
        for (int s = 0; s < NSL; ++s) { const unsigned w = *((const GAS unsigned*)(pd_slice(F.ws, s)) + (size_t)t * 64 + lane); a0 += __uint_as_float(w << 16); a1 += __uint_as_float(w & 0xffff0000u); }
        const float rstd = 1.0f / sqrtf(SSQ[2 * M + t] * (1.f / 1024.f) + RMS_EPS); const f32x2g gt = *((const GAS f32x2g*)(GATE + (size_t)t * 128) + lane);
        unsigned long long o = (unsigned long long)f2bf(gt.x * gelu_erf(a0 * rstd)) | ((unsigned long long)f2bf(gt.y * gelu_erf(a1 * rstd)) << 32);
        *((GAS unsigned long long*)(COEF + (size_t)t * 128) + lane) = o; }
}
__device__ __forceinline__ void p6b_phase(Frame& F) {
    const int lane = mk_lane(), x = (int)(xb_xcc_id() & 7u); const unsigned short* const IDX = (const unsigned short*)(F.ws + WS_IDX); const unsigned* const COEF = (const unsigned*)(F.ws + WS_COEF);
    bf16* const H2B = (bf16*)(F.ws + WS_H2B); float* const ssq2 = (float*)(F.ws + WS_SSQ) + 3 * M;
#pragma unroll 1
    for (int o = 0; o < NSL; ++o) { const int s = slice_order(x, o); gu32* ctr = F.ctl + CW_Q + 64 * (NSL + s); const unsigned char* vs = F.ws + WS_V + (size_t)s * 2 * MiB;
        for (;;) { const int t0 = q_grab(ctr, lane); if (t0 >= M) break;
#pragma unroll 1
            for (int t = t0; t < t0 + 8; ++t) p6b_item(vs, COEF, IDX, F.out, H2B, ssq2, t, s, lane); } }
}
__device__ __forceinline__ void p8_final(Frame& F) {
    const int lane = mk_tid() & 63;
    const int gw = F.vcu * NWAVES + F.wave, NGW = F.G * NWAVES; const float* SSQ = (const float*)(F.ws + WS_SSQ); const f32x4* gr = (const f32x4*)inptr(F, I_GFIN) + lane;
    for (int m = gw; m < M; m += NGW) { GAS f32x4* xr = (GAS f32x4*)(F.out + (size_t)m * D) + lane; const float rs = 1.0f / sqrtf(SSQ[4 * M + m] * (1.f / 1024.f) + RMS_EPS);
#pragma unroll
        for (int j = 0; j < 4; ++j) xr[64 * j] = xr[64 * j] * rs * gr[64 * j]; }
}
struct Args { const float* in[18]; float* out; unsigned char* ws; int ph_lo, ph_hi; };
__global__ void __launch_bounds__(NWAVES * 64, 2) mk_fwd(Args args) {
    extern __shared__ __attribute__((aligned(16))) unsigned char lds[];
    Frame F;
    F.lds = (LAS unsigned char*)lds;
    F.MISC = (volatile LAS unsigned*)(F.lds + MISC_OFF);
    F.wave = __builtin_amdgcn_readfirstlane((int)threadIdx.x >> 6);
    { const int t0 = mk_tid();
    F.G = gridDim.x; { const int bx = blockIdx.x; F.vcu = (F.G % 8 == 0) ? (bx % 8) * (F.G / 8) + bx / 8 : bx; }
    F.ws = args.ws; F.ctl = (gu32*)(args.ws + WS_CTL); F.out = args.out;
      for (int u = t0; u < (LDS_BYTES - LDSCTL_OFF) / 4; u += NWAVES * 64) ((LAS unsigned*)(F.lds + LDSCTL_OFF))[u] = 0u;
      __syncthreads();
      if (t0 < 18) ((LAS unsigned long long*)(F.lds + PTAB_OFF))[t0] = (unsigned long long)args.in[t0];
      __syncthreads(); }
    const int lo = args.ph_lo, hi = args.ph_hi;
    const bool multi = (hi - lo) > 1;
    XcdBarrier bar; bar.bar = (unsigned*)(F.ctl + CW_BAR); bar.x = 0; bar.st = nullptr;
    if (multi) bar = xcd_barrier_post((unsigned*)(F.ctl + CW_BAR), F.MISC + 8, F.wave);
#define IN(k) (lo <= (k) && (k) < hi)
#define BOTH(k) (IN(k) && IN((k) + 1))
#define GRID_BAR() xcd_barrier(bar, F.wave)
    bf16* const XN = (bf16*)(F.ws + WS_XN); bf16* const PROJ = (bf16*)(F.ws + WS_PROJ); bf16* const ATT = (bf16*)(F.ws + WS_ATT); bf16* const PLEB = (bf16*)(F.ws + WS_PLE);
    if (IN(0)) { p0_prologue(F); if (BOTH(0)) GRID_BAR(); }
    if (IN(1)) {
        if (blockIdx.x >= 64 && blockIdx.x < 80) p1_cumsum(F, (int)blockIdx.x - 64);
        { pg8::Gemm g{XN, (const bf16*)(F.ws + WS_WIN), M, NPROJ, D}; pg8::StaticOrder S; S.init(M, NPROJ, F.G, (int)blockIdx.x);
          pg8::EpiProj E{PROJ, (const float*)(F.ws + WS_ROPE)};
          pg8::gemm_phase<pg8::EpiProj, pg8::StaticOrder, true, true>(F.lds + RING_OFF, g, S, E, F.wave); }
        { pg8::Gemm g{(const bf16*)(F.ws + WS_PB), (const bf16*)(F.ws + WS_WPP), M, D, PLE_DIM}; pg8::StaticOrder S; S.init(M, D, 192, blockIdx.x >= 64 ? (int)blockIdx.x - 64 : (1 << 20));
          pg8::EpiBf16 E{PLEB, D};
          pg8::gemm_phase<pg8::EpiBf16, pg8::StaticOrder, true, true>(F.lds + RING_OFF, g, S, E, F.wave); }
        if (BOTH(1)) GRID_BAR();
    }
    if (IN(2)) {
        static_assert(attn_body::ATTN_LDS_BYTES <= 86016 && 86016 + 32768 <= RING_BYTES, "attention LDS map");
        const attn_body::AttnArgs AA{(const attn_body::bf16*)PROJ, (attn_body::bf16*)ATT, (const float*)(F.ws + WS_C), inptr(F, I_SINKS), (float*)(F.ws + WS_SSQ), (float*)(F.ws + WS_SSQ) + M};
        attn_body::attn_phase<8>((char*)lds + RING_OFF, AA, F.vcu, F.G, F.wave);
        if (BOTH(2)) GRID_BAR();
    }
    float* const SSQ = (float*)(F.ws + WS_SSQ);
    bf16* const H1B = (bf16*)(F.ws + WS_XN); bf16* const H2B = (bf16*)(F.ws + WS_H2B);
    if (IN(3)) {
        pg8::Gemm g{ATT, (const bf16*)(F.ws + WS_WOUT), M, D, D}; pg8::StaticOrder S; S.init(M, D, F.G, (int)blockIdx.x);
        LAS float* tab = (LAS float*)(F.lds + TAB_OFF);
        { pg8::Unit u0; const int tt = mk_tid(); if (S.next(0, u0) && tt < 256) { const int row = u0.pm * 256 + tt; const float ra = SSQ[row] * (1.f / 512.f) + RMS_EPS, rb = SSQ[M + row] * (1.f / 512.f) + RMS_EPS;
            tab[tt] = sqrtf(rb / ra); tab[256 + tt] = 1.0f / sqrtf(rb); } }
        __syncthreads();
        pg8::EpiOut E{inptr(F, I_X), F.out, H1B, (const PG8_LAS float*)tab, SSQ + 2 * M};
        pg8::gemm_phase<pg8::EpiOut, pg8::StaticOrder, true, true>(F.lds + RING_OFF, g, S, E, F.wave);
        if (BOTH(3)) GRID_BAR();
    }
    if (IN(4)) {
        pg8::Gemm g{H1B, (const bf16*)(F.ws + WS_WEFF), M, NSC, D};
        pg8::EpiTopK E{SSQ + 2 * M, (unsigned short*)(F.ws + WS_IDX), (float*)(F.ws + WS_GATE)};
#pragma unroll 1
        for (int r = 0; r < 2; ++r) { pg8::RoundOrder S; S.so.init(M, NSC, F.G, (int)blockIdx.x); S.round = r;
            pg8::gemm_phase<pg8::EpiTopK, pg8::RoundOrder, false, true>(F.lds + RING_OFF, g, S, E, F.wave); }
        if (BOTH(4)) GRID_BAR();
    }
    if (IN(5)) { p6a_phase(F); GRID_BAR(); p6c_phase(F); GRID_BAR(); p6b_phase(F); if (BOTH(5)) GRID_BAR(); }
    if (IN(6)) {
        pg8::Gemm g{H2B, (const bf16*)(F.ws + WS_WPG), M, D, D}; pg8::StaticOrder S; S.init(M, D, F.G, (int)blockIdx.x);
        pg8::EpiPle E{F.out, (const bf16*)PLEB, SSQ + 3 * M, SSQ + 4 * M};
        pg8::gemm_phase<pg8::EpiPle, pg8::StaticOrder, true, true>(F.lds + RING_OFF, g, S, E, F.wave);
        if (BOTH(6)) GRID_BAR();
    }
    if (IN(7)) { p8_final(F); }
#undef IN
#undef BOTH
#undef GRID_BAR
}
static int mk_grid() {
    static int grid = 0;
    if (grid == 0) {
        int dev = 0, cus = 0, per_cu = 0;
        if (hipGetDevice(&dev) != hipSuccess || hipDeviceGetAttribute(&cus, hipDeviceAttributeMultiprocessorCount, dev) != hipSuccess) { fprintf(stderr, "kernel_launch: device query failed\n"); grid = -1; return grid; }
        if (hipFuncSetAttribute((const void*)mk_fwd, hipFuncAttributeMaxDynamicSharedMemorySize, LDS_BYTES) != hipSuccess) { fprintf(stderr, "kernel_launch: hipFuncSetAttribute failed\n"); grid = -1; return grid; }
        if (hipOccupancyMaxActiveBlocksPerMultiprocessor(&per_cu, (const void*)mk_fwd, NWAVES * 64, LDS_BYTES) != hipSuccess || per_cu < 1) { fprintf(stderr, "kernel_launch: occupancy query says %d blocks/CU\n", per_cu); grid = -1; (void)hipGetLastError(); return grid; }
        grid = cus;
        if (grid != 256) fprintf(stderr, "kernel_launch: %d CUs (built for 256)\n", grid);
    }
    return grid;
}
static void mk_launch(void* const* d_in, void* d_out, void* d_ws, hipStream_t stream, int lo, int hi) {
    const int grid = mk_grid(); if (grid < 0) return;
    Args a{}; for (int i = 0; i < 18; ++i) a.in[i] = (const float*)d_in[i];
    a.out = (float*)d_out; a.ws = (unsigned char*)d_ws; a.ph_lo = lo; a.ph_hi = hi;
    hipLaunchKernelGGL(mk_fwd, dim3(grid), dim3(NWAVES * 64), LDS_BYTES, stream, a);
    const hipError_t le = hipPeekAtLastError(); if (le != hipSuccess) fprintf(stderr, "kernel_launch: launch [%d,%d) failed: %s\n", lo, hi, hipGetErrorName(le));
}
extern "C" void kernel_launch(void* const* d_in, const int* in_sizes, int n_in, void* d_out, int out_size, void* d_ws, size_t ws_size, hipStream_t stream) {
    if (ws_size < WS_END || n_in != 18 || out_size != M * D) { fprintf(stderr, "kernel_launch: unexpected ws_size / n_in / out_size\n"); return; }
    if (hipMemsetAsync((char*)d_ws + WS_CTL, 0, CTL_ZERO_BYTES, stream) != hipSuccess) { fprintf(stderr, "kernel_launch: memset failed\n"); return; }
    mk_launch(d_in, d_out, d_ws, stream, 0, 8);
}
```
